# Optimizing an MI355X kernel written in HIP

```python
import jax, jax.numpy as jnp
from jax import lax
import numpy as np

D_MODEL = 1024
BATCH = 4
SEQ = 8192
DEPTH = 4
DEC_BATCH = 8
DEC_SEQ = 4096
PAST_LEN = 128

N_MIXERS = 2
HEAD_DIM = 64
E_MIX = D_MODEL
A_GROUPS = ((128, 1), (512, 4), (2048, 16))
N_GROUPS_A = len(A_GROUPS)
H_A = E_MIX // HEAD_DIM
BLK_A = 64
QKV_A = 3 * N_GROUPS_A * E_MIX
IN_A = QKV_A + E_MIX
H_B = E_MIX // HEAD_DIM
KV_B = 4
REP_B = H_B // KV_B
WIN_B = 128
BLK_B = 128
DQ_B = H_B * HEAD_DIM
DKV_B = KV_B * HEAD_DIM
IN_B = DQ_B + 2 * DKV_B + E_MIX
N_LAYERS_A = (DEPTH + 1) // 2
N_LAYERS_B = DEPTH // 2
DEEPNORM_ALPHA = (2.0 * DEPTH) ** 0.25
DEEPNORM_BETA = (8.0 * DEPTH) ** -0.25
LN_EPS = 1e-5

kernel_name = "hybrid_dilated_swa_gqa_encoder"


def _alibi_slopes(n):
    return jnp.asarray(2.0 ** (-8.0 * np.arange(1, n + 1) / n), dtype=jnp.float32)


def _layernorm(h, g, b):
    h32 = h.astype(jnp.float32)
    mu = jnp.mean(h32, axis=-1, keepdims=True)
    var = jnp.mean(jnp.square(h32 - mu), axis=-1, keepdims=True)
    return ((h32 - mu) * lax.rsqrt(var + LN_EPS) * g.astype(jnp.float32) + b.astype(jnp.float32)).astype(h.dtype)


def _dilated_group(q, k, v, dil, n_side, slopes):
    B, S, H, Dh = q.shape
    L = S // dil
    nb = -(-L // BLK_A)
    Lp = nb * BLK_A

    def to_res(t):
        t = t.reshape(B, L, dil, H, Dh).transpose(0, 2, 1, 3, 4)
        return jnp.pad(t, ((0, 0), (0, 0), (0, Lp - L), (0, 0), (0, 0)))

    def band(t):
        t = jnp.pad(t, ((0, 0), (0, 0), (BLK_A, BLK_A), (0, 0), (0, 0))).reshape(B, dil, nb + 2, BLK_A, H, Dh)
        return jnp.concatenate([t[:, :, :-2], t[:, :, 1:-1], t[:, :, 2:]], axis=3)

    qb = to_res(q).reshape(B, dil, nb, BLK_A, H, Dh)
    kb = band(to_res(k))
    vb = band(to_res(v))
    s = jnp.einsum('bgnqhd,bgnkhd->bgnhqk', qb, kb, preferred_element_type=jnp.float32) * (Dh ** -0.5)
    i = jnp.arange(BLK_A)[:, None]
    j = jnp.arange(3 * BLK_A)[None, :]
    rel = j - BLK_A - i
    kpos = jnp.arange(nb)[:, None, None] * BLK_A + (j - BLK_A)[None]
    valid = (jnp.abs(rel) <= n_side)[None] & (kpos >= 0) & (kpos < L)
    bias = -slopes[:, None, None] * (dil * jnp.abs(rel)).astype(jnp.float32)[None]
    s = jnp.where(valid[:, None], s + bias, -jnp.inf)
    m = jnp.max(s, axis=-1, keepdims=True)
    p = jnp.exp(s - m)
    den = jnp.sum(p, axis=-1, keepdims=True)
    o = jnp.einsum('bgnhqk,bgnkhd->bgnqhd', p / den, vb.astype(jnp.float32))
    lse = (m + jnp.log(den))[..., 0]
    o = o.reshape(B, dil, Lp, H, Dh)[:, :, :L].transpose(0, 2, 1, 3, 4).reshape(B, S, H, Dh)
    lse = lse.transpose(0, 1, 2, 4, 3).reshape(B, dil, Lp, H)[:, :, :L].transpose(0, 2, 1, 3).reshape(B, S, H)
    return o, lse


def _mixer_a(u, w_in, w_out):
    B, S, _ = u.shape
    proj = u @ w_in
    qkv = proj[..., :QKV_A].reshape(B, S, N_GROUPS_A, 3, H_A, HEAD_DIM)
    z = proj[..., QKV_A:]
    slopes = _alibi_slopes(H_A)
    outs, lses = [], []
    for g, (win, dil) in enumerate(A_GROUPS):
        o, l = _dilated_group(qkv[:, :, g, 0], qkv[:, :, g, 1], qkv[:, :, g, 2], dil, win // (2 * dil), slopes)
        outs.append(o)
        lses.append(l)
    wts = jax.nn.softmax(jnp.stack(lses), axis=0)[..., None]
    att = jnp.sum(wts * jnp.stack(outs), axis=0).reshape(B, S, E_MIX).astype(u.dtype)
    return (att * jax.nn.silu(z)) @ w_out


def _mixer_b(u, w_in, w_out, sink):
    B, S, _ = u.shape
    nb = S // BLK_B
    proj = u @ w_in
    q = proj[..., :DQ_B].reshape(B, nb, BLK_B, KV_B, REP_B, HEAD_DIM)
    k = proj[..., DQ_B:DQ_B + DKV_B].reshape(B, S, KV_B, HEAD_DIM)
    v = proj[..., DQ_B + DKV_B:DQ_B + 2 * DKV_B].reshape(B, S, KV_B, HEAD_DIM)
    z = proj[..., DQ_B + 2 * DKV_B:]

    def band(t):
        t = jnp.pad(t, ((0, 0), (BLK_B, BLK_B), (0, 0), (0, 0))).reshape(B, nb + 2, BLK_B, KV_B, HEAD_DIM)
        return jnp.concatenate([t[:, :-2], t[:, 1:-1], t[:, 2:]], axis=2)

    kb, vb = band(k), band(v)
    s = jnp.einsum('bnqgrd,bnkgd->bngrqk', q, kb, preferred_element_type=jnp.float32) * (HEAD_DIM ** -0.5)
    i = jnp.arange(BLK_B)[:, None]
    j = jnp.arange(3 * BLK_B)[None, :]
    rel = j - BLK_B - i
    kpos = jnp.arange(nb)[:, None, None] * BLK_B + (j - BLK_B)[None]
    valid = (jnp.abs(rel) <= WIN_B)[None] & (kpos >= 0) & (kpos < S)
    slopes = _alibi_slopes(H_B).reshape(KV_B, REP_B)
    bias = -slopes[:, :, None, None] * jnp.abs(rel).astype(jnp.float32)
    s = jnp.where(valid[:, None, None], s + bias, -jnp.inf)
    snk = sink.astype(jnp.float32).reshape(KV_B, REP_B)[:, :, None, None]
    m = jnp.maximum(jnp.max(s, axis=-1, keepdims=True), snk)
    p = jnp.exp(s - m)
    den = jnp.sum(p, axis=-1, keepdims=True) + jnp.exp(snk - m)
    o = jnp.einsum('bngrqk,bnkgd->bnqgrd', p / den, vb.astype(jnp.float32))
    o = o.reshape(B, S, E_MIX).astype(u.dtype)
    return (o * jax.nn.silu(z)) @ w_out


def _trunk(x, c, w_mod, b_mod, ln_g, ln_b, w_in_a, w_out_a, w_in_b, w_out_b, sink_b):
    for l in range(DEPTH):
        mod = jax.nn.silu(c) @ w_mod[l] + b_mod[l]
        shift, scale, gate = jnp.split(mod[:, None, :], 3, axis=-1)
        u = x * (1 + scale) + shift
        if l % N_MIXERS == 0:
            y = _mixer_a(u, w_in_a[l // N_MIXERS], w_out_a[l // N_MIXERS])
        else:
            y = _mixer_b(u, w_in_b[l // N_MIXERS], w_out_b[l // N_MIXERS], sink_b[l // N_MIXERS])
        x = _layernorm(DEEPNORM_ALPHA * x + gate * y, ln_g[l], ln_b[l])
    return x


def setup_inputs(seed: int = 0) -> dict:
    key = jax.random.key(seed)
    ks = jax.random.split(key, 15)
    f32 = jnp.float32
    d_sc = D_MODEL ** -0.5
    e_sc = E_MIX ** -0.5
    return {
        "x_prompt": jax.random.normal(ks[0], (BATCH, SEQ, D_MODEL), f32),
        "x_sample": jax.random.normal(ks[1], (DEC_BATCH, DEC_SEQ, D_MODEL), f32),
        "c_prompt": jax.random.normal(ks[2], (BATCH, D_MODEL), f32),
        "c_sample": jax.random.normal(ks[3], (DEC_BATCH, D_MODEL), f32),
        "w_mod": jax.random.normal(ks[4], (DEPTH, D_MODEL, 3 * D_MODEL), f32) * (0.5 * d_sc),
        "b_mod": jax.random.normal(ks[5], (DEPTH, 3 * D_MODEL), f32) * 0.01,
        "ln_g": 1.0 + 0.02 * jax.random.normal(ks[6], (DEPTH, D_MODEL), f32),
        "ln_b": 0.02 * jax.random.normal(ks[7], (DEPTH, D_MODEL), f32),
        "w_in_a": jax.random.normal(ks[8], (N_LAYERS_A, D_MODEL, IN_A), f32) * d_sc,
        "w_out_a": jax.random.normal(ks[9], (N_LAYERS_A, E_MIX, D_MODEL), f32) * (e_sc * DEEPNORM_BETA),
        "w_in_b": jax.random.normal(ks[10], (N_LAYERS_B, D_MODEL, IN_B), f32) * d_sc,
        "w_out_b": jax.random.normal(ks[11], (N_LAYERS_B, E_MIX, D_MODEL), f32) * (e_sc * DEEPNORM_BETA),
        "sink_b": jax.random.normal(ks[12], (N_LAYERS_B, H_B), f32),
    }


def reference(x_prompt, x_sample, c_prompt, c_sample, w_mod, b_mod, ln_g, ln_b,
              w_in_a, w_out_a, w_in_b, w_out_b, sink_b):
    y_prompt = _trunk(x_prompt, c_prompt, w_mod, b_mod, ln_g, ln_b, w_in_a, w_out_a, w_in_b, w_out_b, sink_b)
    y_sample = _trunk(x_sample, c_sample, w_mod, b_mod, ln_g, ln_b, w_in_a, w_out_a, w_in_b, w_out_b, sink_b)
    return (y_prompt, y_sample)
```

```cpp
#include <hip/hip_runtime.h>
#include <hip/hip_cooperative_groups.h>
#include <cstdio>
#include <cstdint>
namespace cg = cooperative_groups;
namespace pg8 {
#define PG8_LAS __attribute__((address_space(3)))
typedef unsigned short bf16_t;
typedef short bf16x8 __attribute__((ext_vector_type(8)));
typedef float f32x4 __attribute__((ext_vector_type(4)));
typedef unsigned u32x4 __attribute__((ext_vector_type(4)));
constexpr int BM = 256, BK = 64, HALF = 128, HTB = HALF * BK * 2  , STAGE_BYTES = 8 * HTB, NXCD = 8, WGM = 8;

__host__ __device__ __forceinline__ int lds_byte(int r, int c) { const int st = (r >> 4) * 2 + (c >> 5), rr = r & 15, cc = c & 31, ob = rr * 64 + cc * 2; return st * 1024 + (ob ^ (((ob >> 9) & 1) << 5)); }
__host__ __device__ __forceinline__ void stage_rc(int b, int& R, int& C) { const int st = b / 1024, sb = b % 1024, swz = sb ^ (((sb >> 9) & 1) << 5); R = (st >> 1) * 16 + swz / 64; C = (st & 1) * 32 + (swz % 64) / 2; }
__host__ __device__ __forceinline__ int perm32(int rho) { const int n = rho >> 4, i = rho & 15; return 8 * (i >> 2) + 4 * n + (i & 3); }

struct Unit { int pm, pn; };
struct Gemm { const bf16_t* A; const bf16_t* Bt; int M, N, K; };

struct StaticOrder {
    int nM, nN, nwg, G, c;
    __host__ __device__ void init(int M, int N, int G_, int c_) { nM = M / BM; nN = N / BM; nwg = nM * nN; G = G_; c = c_; }
    __host__ __device__ bool next(int i, Unit& u) const {
        const long L = (long)i * G + c; if (L >= nwg) return false;
        int wgid = (int)L; { const int q = nwg / NXCD, r = nwg % NXCD, xcd = wgid % NXCD, off = wgid / NXCD; wgid = (xcd < r ? xcd * (q + 1) : r * (q + 1) + (xcd - r) * q) + off; }
        const int nig = WGM * nN, gid = wgid / nig, fm = gid * WGM, gsz = (nM - fm) < WGM ? (nM - fm) : WGM;
        u.pm = fm + ((wgid % nig) % gsz); u.pn = (wgid % nig) / gsz; return true;
    }
    __device__ __forceinline__ void a_ready(const Unit&) const {}
    __device__ __forceinline__ void done(const Unit&) const {}
};

__device__ __forceinline__ unsigned cvt_pk_bf16(float lo, float hi) { unsigned r; asm volatile("v_cvt_pk_bf16_f32 %0, %1, %2" : "=v"(r) : "v"(lo), "v"(hi)); return r; }
typedef float f32x2 __attribute__((ext_vector_type(2)));
__device__ __forceinline__ f32x2 gelu_pk(f32x2 v) {
    const f32x2 av = __builtin_elementwise_abs(v), d = av * 0.2316418882f + 1.0f;
    f32x2 t; t.x = __builtin_amdgcn_rcpf(d.x); t.y = __builtin_amdgcn_rcpf(d.y);
    f32x2 q = t * 0.5307027145f + (-0.7265760135f); q = q * t + 0.7107068705f; q = q * t + (-0.142248368f); q = q * t + 0.127414796f; q = q * t;
    const f32x2 s = (v * v) * (-0.72134752044f);
    f32x2 e; e.x = __builtin_amdgcn_exp2f(s.x); e.y = __builtin_amdgcn_exp2f(s.y);
    const f32x2 m = v * (q * e), r = v - m;
    f32x2 o; o.x = v.x < 0.f ? m.x : r.x; o.y = v.y < 0.f ? m.y : r.y; return o;
}

template <int ACT  > struct EpiBf16 {
    static constexpr bool PERM = true, AFTER_DRAIN = false; static_assert(ACT == 0 || ACT == 1, "EpiBf16: ACT is 0 (none) or 1 (gelu_pk)");
    bf16_t* O; int ldc; const float* bias; int split_cols; size_t split_stride; float scale0;
    __device__ __forceinline__ void operator()(const f32x4 (&acc)[2][2][4][2], const Unit& u, int wr, int wc, int fr, int fq) const {
        const int row0 = u.pm * BM + wr * 64 + fr; int colt = u.pn * BM; bf16_t* base = O;
        float sc = 1.f; if (split_cols) { const int t = colt / split_cols; base += (size_t)t * split_stride; colt -= t * split_cols; if (t == 0) sc = scale0; }
        const int col0 = colt + wc * 32 + 8 * fq, bcol0 = u.pn * BM + wc * 32 + 8 * fq;
        f32x4 bv[2][2];
#pragma unroll
        for (int bj = 0; bj < 2; ++bj)
#pragma unroll
            for (int n = 0; n < 2; ++n) bv[bj][n] = bias ? *(const f32x4*)(bias + bcol0 + bj * HALF + 4 * n) : (f32x4){0.f, 0.f, 0.f, 0.f};
#pragma unroll
        for (int ai = 0; ai < 2; ++ai)
#pragma unroll
            for (int m = 0; m < 4; ++m) { bf16_t* rowp = base + (size_t)(row0 + ai * HALF + m * 16) * ldc + col0;
#pragma unroll
                for (int bj = 0; bj < 2; ++bj) { f32x4 v0 = acc[ai][bj][m][0] + bv[bj][0], v1 = acc[ai][bj][m][1] + bv[bj][1];
                    if (ACT == 1) { f32x2 a = gelu_pk((f32x2){v0[0], v0[1]}), b = gelu_pk((f32x2){v0[2], v0[3]}), c = gelu_pk((f32x2){v1[0], v1[1]}), d = gelu_pk((f32x2){v1[2], v1[3]});
                        v0 = (f32x4){a.x, a.y, b.x, b.y}; v1 = (f32x4){c.x, c.y, d.x, d.y}; }
                    v0 = v0 * sc; v1 = v1 * sc; u32x4 w; w.x = cvt_pk_bf16(v0[0], v0[1]); w.y = cvt_pk_bf16(v0[2], v0[3]); w.z = cvt_pk_bf16(v1[0], v1[1]); w.w = cvt_pk_bf16(v1[2], v1[3]);
                    *(u32x4*)(rowp + bj * HALF) = w; } }
    }
};
struct EpiRes {
    static constexpr bool PERM = false, AFTER_DRAIN = false;
    const float* xa; const float* xb; float* out; const float* gate_base; float alpha;
    __device__ __forceinline__ void operator()(const f32x4 (&acc)[2][2][4][2], const Unit& u, int wr, int wc, int fr, int fq) const {
        const int rowt = u.pm * BM;
        const int b = rowt < 32768 ? (rowt >> 13) : 4 + ((rowt - 32768) >> 12);
        const float* xs = rowt < 32768 ? xa + (size_t)rowt * 1024 : xb + (size_t)(rowt - 32768) * 1024;
        float* os = out + (size_t)rowt * 1024;
        const float* gp = gate_base + b * 3072;
        const int col0 = u.pn * BM + wc * 32 + 4 * fq;
        f32x4 gv[2][2];
#pragma unroll
        for (int bj = 0; bj < 2; ++bj)
#pragma unroll
            for (int n = 0; n < 2; ++n) gv[bj][n] = *(const f32x4*)(gp + col0 + bj * HALF + n * 16);
#pragma unroll
        for (int ai = 0; ai < 2; ++ai)
#pragma unroll
            for (int m = 0; m < 4; ++m) { const size_t off = (size_t)(wr * 64 + fr + ai * HALF + m * 16) * 1024 + col0;
#pragma unroll
                for (int bj = 0; bj < 2; ++bj)
#pragma unroll
                    for (int n = 0; n < 2; ++n) { const f32x4 xv = *(const f32x4*)(xs + off + bj * HALF + n * 16);
                        *(f32x4*)(os + off + bj * HALF + n * 16) = xv * alpha + gv[bj][n] * acc[ai][bj][m][n]; } }
    }
};
template <class Epi, class Sched, bool ALIGN_EPI = false, bool SP2 = false>
__device__ __forceinline__ void gemm_phase(PG8_LAS unsigned char* lds, const Gemm g, const Sched& S, const Epi& E) {
    int tid_l = threadIdx.x; asm volatile("" : "+v"(tid_l));
    const int tid = tid_l, wid = __builtin_amdgcn_readfirstlane(tid >> 6), lane = tid & 63, wr = wid >> 2, wc = wid & 3, fr = lane & 15, fq = lane >> 4;
    const int K = g.K, nt = K / BK;
    unsigned voffA[2], voffB[2];
#pragma unroll
    for (int i = 0; i < 2; ++i) { int R, C; stage_rc(tid * 16 + i * 8192, R, C); const int Rb = Epi::PERM ? ((R & ~31) + perm32(R & 31)) : R;
        voffA[i] = (unsigned)(R * K + C) * 2u; voffB[i] = (unsigned)(Rb * K + C) * 2u; }
    const size_t kstep = (size_t)(BK * 2);
    const size_t hstep = (size_t)HALF * K * 2;
    const size_t tstep = 2 * hstep;
    const unsigned ldsw = (unsigned)wid * 1024u;
    const int aoff = lds_byte(wr * 64 + fr, fq * 8), boff = lds_byte(wc * 32 + fr, fq * 8);
#define PG8_SA(b, h) (((b) * 2 + (h)) * HTB)
#define PG8_SB(b, h) ((4 + (b) * 2 + (h)) * HTB)
#define PG8_STAGE(bufoff, gbase, voff) do { _Pragma("unroll") for (int _i = 0; _i < 2; ++_i) \
        __builtin_amdgcn_global_load_lds((const unsigned*)((const char*)(gbase) + (voff)[_i]), (PG8_LAS unsigned*)(lds + (bufoff) + ldsw + _i * 8192), 16, 0, 0); } while (0)
#define PG8_LDA(dst, b, h) do { _Pragma("unroll") for (int m = 0; m < 4; ++m) _Pragma("unroll") for (int k = 0; k < 2; ++k) dst[m][k] = *(const PG8_LAS bf16x8*)(lds + PG8_SA(b, h) + aoff + m * 2048 + k * 1024); } while (0)
#define PG8_LDB(dst, b, h) do { _Pragma("unroll") for (int n = 0; n < 2; ++n) _Pragma("unroll") for (int k = 0; k < 2; ++k) dst[n][k] = *(const PG8_LAS bf16x8*)(lds + PG8_SB(b, h) + boff + n * 2048 + k * 1024); } while (0)
#define PG8_MMA(ai, bj, At, Bt) do { __builtin_amdgcn_s_setprio(1); _Pragma("unroll") for (int m = 0; m < 4; ++m) _Pragma("unroll") for (int n = 0; n < 2; ++n) _Pragma("unroll") for (int k = 0; k < 2; ++k) \
        acc[ai][bj][m][n] = __builtin_amdgcn_mfma_f32_16x16x32_bf16(Bt[n][k], At[m][k], acc[ai][bj][m][n], 0, 0, 0); __builtin_amdgcn_s_setprio(0); } while (0)
#define PG8_WAIT_V(n) asm volatile("s_waitcnt vmcnt(" #n ")" ::: "memory")
#define PG8_WAIT_L(n) asm volatile("s_waitcnt lgkmcnt(" #n ")" ::: "memory")
#define PG8_BAR __builtin_amdgcn_s_barrier()
#define PG8_SCHED __builtin_amdgcn_sched_barrier(0)
    Unit cur, nxt; int ui = 0;
    if (!S.next(0, cur)) return;
    f32x4 acc[2][2][4][2];
#pragma unroll
    for (int a = 0; a < 2; ++a)
#pragma unroll
        for (int b = 0; b < 2; ++b)
#pragma unroll
            for (int m = 0; m < 4; ++m)
#pragma unroll
                for (int n = 0; n < 2; ++n) acc[a][b][m][n] = (f32x4){0.f, 0.f, 0.f, 0.f};
    bf16x8 At[4][2], B0[2][2], B1[2][2];
    const char* cA = (const char*)g.A + (size_t)cur.pm * tstep; const char* cB = (const char*)g.Bt + (size_t)cur.pn * tstep;
    S.a_ready(cur);
    if constexpr (SP2) {
        PG8_STAGE(PG8_SB(0, 0), cB, voffB); PG8_STAGE(PG8_SB(0, 1), cB + hstep, voffB); PG8_STAGE(PG8_SA(0, 0), cA, voffA); PG8_STAGE(PG8_SA(0, 1), cA + hstep, voffA);
        if (wr == 1) PG8_BAR;
        PG8_WAIT_V(2); PG8_BAR;
        PG8_STAGE(PG8_SB(1, 0), cB + kstep, voffB); PG8_STAGE(PG8_SA(1, 0), cA + kstep, voffA); PG8_STAGE(PG8_SB(1, 1), cB + hstep + kstep, voffB);
        PG8_WAIT_V(6); PG8_BAR;
    } else {
        PG8_STAGE(PG8_SB(0, 0), cB, voffB); PG8_STAGE(PG8_SA(0, 0), cA, voffA); PG8_STAGE(PG8_SB(0, 1), cB + hstep, voffB); PG8_STAGE(PG8_SA(0, 1), cA + hstep, voffA);
        if (wr == 1) PG8_BAR;
        PG8_WAIT_V(4); PG8_BAR;
        PG8_STAGE(PG8_SB(1, 0), cB + kstep, voffB); PG8_STAGE(PG8_SA(1, 0), cA + kstep, voffA); PG8_STAGE(PG8_SB(1, 1), cB + hstep + kstep, voffB);
        PG8_WAIT_V(6); PG8_BAR;
    }
    for (;;) {
        const bool has_next = S.next(ui + 1, nxt);
        const char* nA = has_next ? (const char*)g.A + (size_t)nxt.pm * tstep : cA; const char* nB = has_next ? (const char*)g.Bt + (size_t)nxt.pn * tstep : cB;
        for (int t = 0; t < nt; t += 2) {
            const bool last = (t == nt - 2);
            const char* a1 = cA + (size_t)(t + 1) * kstep;
            const char* a2 = last ? nA : cA + (size_t)(t + 2) * kstep; const char* b2 = last ? nB : cB + (size_t)(t + 2) * kstep;
            const char* a3 = a2 + kstep; const char* b3 = b2 + kstep;
            if (last && has_next) S.a_ready(nxt);
            if constexpr (SP2) {
            PG8_LDB(B0, 0, 0); PG8_LDB(B1, 0, 1); PG8_SCHED; PG8_LDA(At, 0, 0); PG8_STAGE(PG8_SA(1, 1), a1 + hstep, voffA);
            PG8_WAIT_V(8); PG8_WAIT_L(0); PG8_BAR; PG8_MMA(0, 0, At, B0); PG8_MMA(0, 1, At, B1); PG8_BAR; PG8_SCHED;
            PG8_LDA(At, 0, 1); PG8_STAGE(PG8_SB(0, 0), b2, voffB); PG8_STAGE(PG8_SB(0, 1), b2 + hstep, voffB); PG8_STAGE(PG8_SA(0, 0), a2, voffA);
            PG8_WAIT_V(8); PG8_WAIT_L(0); PG8_BAR; PG8_MMA(1, 0, At, B0); PG8_MMA(1, 1, At, B1); PG8_BAR; PG8_SCHED;
            PG8_LDB(B0, 1, 0); PG8_LDB(B1, 1, 1); PG8_SCHED; PG8_LDA(At, 1, 0); PG8_STAGE(PG8_SA(0, 1), a2 + hstep, voffA);
            PG8_WAIT_V(8); PG8_WAIT_L(0); PG8_BAR; PG8_MMA(0, 0, At, B0); PG8_MMA(0, 1, At, B1); PG8_BAR; PG8_SCHED;
            PG8_LDA(At, 1, 1); PG8_STAGE(PG8_SB(1, 0), b3, voffB); PG8_STAGE(PG8_SB(1, 1), b3 + hstep, voffB); PG8_STAGE(PG8_SA(1, 0), a3, voffA);
            PG8_WAIT_V(8); PG8_WAIT_L(0); PG8_BAR; PG8_MMA(1, 0, At, B0); PG8_MMA(1, 1, At, B1); PG8_BAR; PG8_SCHED;
            } else {
            PG8_LDB(B0, 0, 0); PG8_SCHED; PG8_LDA(At, 0, 0); PG8_STAGE(PG8_SA(1, 1), a1 + hstep, voffA);
            PG8_WAIT_L(8); PG8_BAR; PG8_WAIT_L(0); PG8_MMA(0, 0, At, B0); PG8_BAR; PG8_SCHED;
            PG8_LDB(B1, 0, 1); PG8_STAGE(PG8_SB(0, 0), b2, voffB);
            PG8_BAR; PG8_WAIT_L(0); PG8_MMA(0, 1, At, B1); PG8_BAR;
            PG8_LDA(At, 0, 1); PG8_STAGE(PG8_SA(0, 0), a2, voffA);
            PG8_BAR; PG8_WAIT_L(0); PG8_MMA(1, 0, At, B0); PG8_BAR; PG8_SCHED;
            PG8_STAGE(PG8_SB(0, 1), b2 + hstep, voffB);
            PG8_WAIT_V(6); PG8_BAR; PG8_MMA(1, 1, At, B1); PG8_BAR;
            PG8_LDB(B0, 1, 0); PG8_SCHED; PG8_LDA(At, 1, 0); PG8_STAGE(PG8_SA(0, 1), a2 + hstep, voffA);
            PG8_WAIT_L(8); PG8_BAR; PG8_WAIT_L(0); PG8_MMA(0, 0, At, B0); PG8_BAR; PG8_SCHED;
            PG8_LDB(B1, 1, 1); PG8_STAGE(PG8_SB(1, 0), b3, voffB);
            PG8_BAR; PG8_WAIT_L(0); PG8_MMA(0, 1, At, B1); PG8_BAR;
            PG8_LDA(At, 1, 1); PG8_STAGE(PG8_SA(1, 0), a3, voffA);
            PG8_BAR; PG8_WAIT_L(0); PG8_MMA(1, 0, At, B0); PG8_BAR; PG8_SCHED;
            PG8_STAGE(PG8_SB(1, 1), b3 + hstep, voffB);
            PG8_WAIT_V(6); PG8_BAR; PG8_MMA(1, 1, At, B1); PG8_BAR;
            }
        }
        if constexpr (ALIGN_EPI) { if (wr == 0) PG8_BAR; }
        if constexpr (!Epi::AFTER_DRAIN) { E(acc, cur, wr, wc, fr, fq); S.done(cur); }
        if (!has_next) break;
#pragma unroll
        for (int a = 0; a < 2; ++a)
#pragma unroll
            for (int b = 0; b < 2; ++b)
#pragma unroll
                for (int m = 0; m < 4; ++m)
#pragma unroll
                    for (int n = 0; n < 2; ++n) acc[a][b][m][n] = (f32x4){0.f, 0.f, 0.f, 0.f};
        cur = nxt; cA = nA; cB = nB; ++ui;
        if constexpr (ALIGN_EPI) { if (wr == 1) PG8_BAR; }
    }
    PG8_WAIT_V(0);
    if constexpr (!ALIGN_EPI) { if (wr == 0) PG8_BAR; }
    PG8_BAR;
    if constexpr (Epi::AFTER_DRAIN) { E.fused(acc, cur, wr, wc, fr, fq, lds, wid, lane); S.done(cur); }
#undef PG8_SA
#undef PG8_SB
#undef PG8_STAGE
#undef PG8_LDA
#undef PG8_LDB
#undef PG8_MMA
#undef PG8_WAIT_V
#undef PG8_WAIT_L
#undef PG8_BAR
#undef PG8_SCHED
}
}
constexpr int DM = 1024, NTOK = 65536, NPROMPT = 32768, NB = 12, DEPTH = 4;
constexpr int IN_A = 10240, IN_B = 2560;
constexpr int CH_A = 8192, NCH_A = 8, CH_B = 32768, NCH_B = 2;
constexpr float LN_EPS = 1e-5f;
constexpr float LOG2E = 1.4426950408889634f;
constexpr float CSCALE = 0.125f * LOG2E;
constexpr size_t MiB = 1u << 20;
constexpr size_t WS_MOD = 0, CTL_ZERO_BYTES = 1 * MiB;
constexpr size_t WS_WINA = 2 * MiB;
constexpr size_t WS_WOUTA = 42 * MiB;
constexpr size_t WS_WINB = 46 * MiB;
constexpr size_t WS_WOUTB = 56 * MiB;
constexpr size_t WS_U = 64 * MiB;
constexpr size_t WS_ATT = 192 * MiB;
constexpr size_t WS_PROJ = 320 * MiB;
constexpr size_t WS_END = 480 * MiB;
constexpr int LDS_BYTES = 147456;
constexpr int NWAVES = 8;

#define LAS __attribute__((address_space(3)))
typedef unsigned short bf16_t;
typedef short bf16x8 __attribute__((ext_vector_type(8)));
typedef short s16x4 __attribute__((ext_vector_type(4)));
typedef float f32x4 __attribute__((ext_vector_type(4)));
typedef float f32x2 __attribute__((ext_vector_type(2)));
typedef unsigned u32x4 __attribute__((ext_vector_type(4)));
typedef unsigned u32x2 __attribute__((ext_vector_type(2)));
typedef __bf16 bf16x2_t __attribute__((ext_vector_type(2)));
typedef short v4i16_t __attribute__((ext_vector_type(4)));

__device__ __forceinline__ unsigned cvtpk(float lo, float hi) { f32x2 v = {lo, hi}; bf16x2_t b = __builtin_convertvector(v, bf16x2_t); return __builtin_bit_cast(unsigned, b); }
__device__ __forceinline__ float bf_lo(unsigned w) { return __uint_as_float(w << 16); }
__device__ __forceinline__ float bf_hi(unsigned w) { return __uint_as_float(w & 0xffff0000u); }
__device__ __forceinline__ float silu_f(float z) { return z / (1.f + __expf(-z)); }
__device__ __forceinline__ int batch_of_row(int row) { return row < NPROMPT ? (row >> 13) : 4 + ((row - NPROMPT) >> 12); }
__device__ __forceinline__ float wave_sum(float v) {
#pragma unroll
    for (int o = 1; o < 64; o <<= 1) v += __shfl_xor(v, o);
    return v;
}

template <int D_, int NS, int QSTEP, int NSTEPS>
__device__ __forceinline__ void group_pass(const bf16_t* __restrict__ Pq, const bf16_t* __restrict__ Pk, const bf16_t* __restrict__ Pv, int pitch, int S, int t0, int tq,
                                           float slope2, LAS unsigned char* vl, int lane, float& m, float& l, f32x4 (&o)[4]) {
    const int i = lane & 15, g = lane >> 4;
    bf16x8 qb[2];
#pragma unroll
    for (int s = 0; s < 2; ++s) qb[s] = *(const bf16x8*)(Pq + (size_t)tq * pitch + 8 * g + 32 * s);
    const float relbase = (float)(-NS + 4 * g - QSTEP * i);
    const int lo_i = -(tq / D_), hi_i = (S - 1 - tq) / D_;
    const float lo = (float)(lo_i > -NS ? lo_i : -NS), hi = (float)(hi_i < NS ? hi_i : NS);
    const int vk = lane >> 3, vc = lane & 7;
    const bf16_t* kp = Pk + 8 * g;
    const bf16_t* vp = Pv + 8 * vc;
    LAS unsigned char* vw = vl + vk * 160 + vc * 16;
    LAS unsigned char* vb = vl + (4 * g + ((lane & 15) >> 2)) * 160 + 8 * (lane & 3);
    bf16x8 kn[2][2]; u32x4 vn[4];
#define ATT_LOAD(st_) do { \
        _Pragma("unroll") for (int t_ = 0; t_ < 2; ++t_) { int tk = t0 + D_ * (32 * (st_) + 16 * t_ + i - NS); tk = tk < 0 ? 0 : (tk > S - 1 ? S - 1 : tk); \
            _Pragma("unroll") for (int s = 0; s < 2; ++s) kn[t_][s] = *(const bf16x8*)(kp + (size_t)tk * pitch + 32 * s); } \
        _Pragma("unroll") for (int c = 0; c < 4; ++c) { int tk = t0 + D_ * (32 * (st_) + 8 * c + vk - NS); tk = tk < 0 ? 0 : (tk > S - 1 ? S - 1 : tk); \
            vn[c] = *(const u32x4*)(vp + (size_t)tk * pitch); } } while (0)
    ATT_LOAD(0);
#pragma unroll 1
    for (int st = 0; st < NSTEPS; ++st) {
        bf16x8 kc[2][2]; u32x4 vcur[4];
#pragma unroll
        for (int t_ = 0; t_ < 2; ++t_)
#pragma unroll
            for (int s = 0; s < 2; ++s) kc[t_][s] = kn[t_][s];
#pragma unroll
        for (int c = 0; c < 4; ++c) vcur[c] = vn[c];
        if (st + 1 < NSTEPS) ATT_LOAD(st + 1);
#pragma unroll
        for (int c = 0; c < 4; ++c) *(LAS u32x4*)(vw + c * 1280) = vcur[c];
        f32x4 sa[2];
#pragma unroll
        for (int t_ = 0; t_ < 2; ++t_) {
            sa[t_] = __builtin_amdgcn_mfma_f32_16x16x32_bf16(kc[t_][0], qb[0], (f32x4){0.f, 0.f, 0.f, 0.f}, 0, 0, 0);
            sa[t_] = __builtin_amdgcn_mfma_f32_16x16x32_bf16(kc[t_][1], qb[1], sa[t_], 0, 0, 0);
        }
        const float rb = relbase + (float)(32 * st);
        float sc[8];
#pragma unroll
        for (int t_ = 0; t_ < 2; ++t_)
#pragma unroll
            for (int r = 0; r < 4; ++r) {
                const float relf = rb + (float)(16 * t_ + r);
                const float v = fmaf(-slope2, fabsf(relf), sa[t_][r] * CSCALE);
                sc[4 * t_ + r] = (relf >= lo && relf <= hi) ? v : -1e30f;
            }
        float mx = fmaxf(fmaxf(fmaxf(sc[0], sc[1]), fmaxf(sc[2], sc[3])), fmaxf(fmaxf(sc[4], sc[5]), fmaxf(sc[6], sc[7])));
        mx = fmaxf(mx, __shfl_xor(mx, 16)); mx = fmaxf(mx, __shfl_xor(mx, 32));
        const float mn = fmaxf(m, mx), alpha = __builtin_amdgcn_exp2f(m - mn); m = mn;
        float ps = 0.f;
#pragma unroll
        for (int k = 0; k < 8; ++k) { sc[k] = __builtin_amdgcn_exp2f(sc[k] - mn); ps += sc[k]; }
        l = l * alpha + ps;
#pragma unroll
        for (int n = 0; n < 4; ++n) o[n] = o[n] * alpha;
        u32x4 pw; pw.x = cvtpk(sc[0], sc[1]); pw.y = cvtpk(sc[2], sc[3]); pw.z = cvtpk(sc[4], sc[5]); pw.w = cvtpk(sc[6], sc[7]);
        const bf16x8 pb = __builtin_bit_cast(bf16x8, pw);
#pragma unroll
        for (int n = 0; n < 4; ++n) {
            const s16x4 v0 = __builtin_bit_cast(s16x4, __builtin_amdgcn_ds_read_tr16_b64_v4i16((LAS v4i16_t*)(vb + n * 32)));
            const s16x4 v1 = __builtin_bit_cast(s16x4, __builtin_amdgcn_ds_read_tr16_b64_v4i16((LAS v4i16_t*)(vb + n * 32 + 2560)));
            const bf16x8 va = (bf16x8){v0[0], v0[1], v0[2], v0[3], v1[0], v1[1], v1[2], v1[3]};
            o[n] = __builtin_amdgcn_mfma_f32_16x16x32_bf16(va, pb, o[n], 0, 0, 0);
        }
    }
#undef ATT_LOAD
}

__device__ __forceinline__ void attn_store(const bf16_t* __restrict__ Pz, int pitch, int tq, bf16_t* __restrict__ orow0  , int lane, float l, const f32x4 (&o)[4]) {
    const int g = lane >> 4;
    float lt = l + __shfl_xor(l, 16); lt = lt + __shfl_xor(lt, 32);
    const float inv = 1.f / lt;
#pragma unroll
    for (int n = 0; n < 4; ++n) {
        const u32x2 zw = *(const u32x2*)(Pz + (size_t)tq * pitch + 16 * n + 4 * g);
        const float a0 = o[n][0] * inv * silu_f(bf_lo(zw.x)), a1 = o[n][1] * inv * silu_f(bf_hi(zw.x));
        const float a2 = o[n][2] * inv * silu_f(bf_lo(zw.y)), a3 = o[n][3] * inv * silu_f(bf_hi(zw.y));
        u32x2 w; w.x = cvtpk(a0, a1); w.y = cvtpk(a2, a3);
        *(u32x2*)(orow0 + (size_t)tq * 1024 + 16 * n + 4 * g) = w;
    }
}

__device__ __forceinline__ void attn_a_phase(const bf16_t* P, bf16_t* A, int S, LAS unsigned char* lds, int wave, int lane_in) {
    int lane = lane_in; asm volatile("" : "+v"(lane));
    LAS unsigned char* vl = lds + wave * 5120;
    for (int bu = blockIdx.x; bu < 256; bu += gridDim.x) {
        const int tile = bu >> 3, hp = bu & 7;
#pragma unroll 1
        for (int it = 0; it < 4; ++it) {
            const int idx = it * 8 + wave, h = 2 * hp + (idx >> 4), res = idx & 15;
            const int tc = tile * 256 + res, seq0 = (tc / S) * S, t0 = tc - seq0, tq = t0 + 16 * (lane & 15);
            const bf16_t* Ps = P + (size_t)seq0 * IN_A + h * 64;
            const float slope = __builtin_amdgcn_exp2f(-0.5f * (float)(h + 1)) * LOG2E;
            float m = -1e30f, l = 0.f; f32x4 o[4];
#pragma unroll
            for (int n = 0; n < 4; ++n) o[n] = (f32x4){0.f, 0.f, 0.f, 0.f};
            group_pass<1, 64, 16, 12>(Ps, Ps + 1024, Ps + 2048, IN_A, S, t0, tq, slope, vl, lane, m, l, o);
            group_pass<4, 64, 4, 6>(Ps + 3072, Ps + 4096, Ps + 5120, IN_A, S, t0, tq, slope * 4.f, vl, lane, m, l, o);
            group_pass<16, 64, 1, 5>(Ps + 6144, Ps + 7168, Ps + 8192, IN_A, S, t0, tq, slope * 16.f, vl, lane, m, l, o);
            attn_store(Ps + 9216, IN_A, tq, A + (size_t)seq0 * 1024 + h * 64, lane, l, o);
        }
    }
}
__device__ __forceinline__ void attn_b_phase(const bf16_t* P, bf16_t* A, int S, const float* sink, LAS unsigned char* lds, int wave, int lane_in) {
    int lane = lane_in; asm volatile("" : "+v"(lane));
    LAS unsigned char* vl = lds + wave * 5120;
    for (int bu = blockIdx.x; bu < 256; bu += gridDim.x) {
        const int tile = bu >> 1, hh = bu & 1;
#pragma unroll 1
        for (int it = 0; it < 16; ++it) {
            const int idx = it * 8 + wave, h = 8 * hh + (idx >> 4), sub = idx & 15;
            const int tc = tile * 256 + 16 * sub, seq0 = (tc / S) * S, t0 = tc - seq0, tq = t0 + (lane & 15);
            const bf16_t* Ps = P + (size_t)seq0 * IN_B;
            const float slope = __builtin_amdgcn_exp2f(-0.5f * (float)(h + 1)) * LOG2E;
            float m = sink[h] * LOG2E, l = (lane < 16) ? 1.f : 0.f; f32x4 o[4];
#pragma unroll
            for (int n = 0; n < 4; ++n) o[n] = (f32x4){0.f, 0.f, 0.f, 0.f};
            group_pass<1, 128, 1, 9>(Ps + h * 64, Ps + 1024 + (h >> 2) * 64, Ps + 1280 + (h >> 2) * 64, IN_B, S, t0, tq, slope, vl, lane, m, l, o);
            attn_store(Ps + 1536 + h * 64, IN_B, tq, A + (size_t)seq0 * 1024 + h * 64, lane, l, o);
        }
    }
}

__device__ __forceinline__ unsigned f2bf(float f) { unsigned u = __builtin_bit_cast(unsigned, f); return (u + 0x7fffu + ((u >> 16) & 1u)) >> 16; }
__device__ __forceinline__ unsigned pk2(float lo, float hi) { return f2bf(lo) | (f2bf(hi) << 16); }
__device__ __forceinline__ void transpose_item(const float* __restrict__ W, int K, int N, bf16_t* __restrict__ WT, LAS float* scr, int item, int lane) {
    const int nblk = N / 32, kb = item / nblk, nb = item % nblk, k0 = 64 * kb, n0 = 32 * nb;
#pragma unroll 8
    for (int i = 0; i < 32; ++i) { const int kk = 2 * i + (lane >> 5); scr[kk * 33 + (lane & 31)] = W[(size_t)(k0 + kk) * N + n0 + (lane & 31)]; }
    asm volatile("s_waitcnt lgkmcnt(0)" ::: "memory");
    const int c = lane & 7;
#pragma unroll
    for (int j = 0; j < 4; ++j) { const int n = (lane >> 3) + 8 * j; const LAS float* s = scr + (8 * c) * 33 + n;
        u32x4 o; o.x = pk2(s[0 * 33], s[1 * 33]); o.y = pk2(s[2 * 33], s[3 * 33]); o.z = pk2(s[4 * 33], s[5 * 33]); o.w = pk2(s[6 * 33], s[7 * 33]);
        *(u32x4*)(WT + (size_t)(n0 + n) * K + k0 + 8 * c) = o; }
    asm volatile("s_waitcnt lgkmcnt(0)" ::: "memory");
}

struct Args {
    const float *x_prompt, *x_sample, *c_prompt, *c_sample, *w_mod, *b_mod, *ln_g, *ln_b, *w_in_a, *w_out_a, *w_in_b, *w_out_b, *sink_b;
    float* out; unsigned char* ws; int ph_lo, ph_hi;
};

__global__ void __launch_bounds__(NWAVES * 64, 2) mk_fwd(Args a) {
    extern __shared__ __attribute__((aligned(16))) unsigned char lds_raw[];
    LAS unsigned char* lds = (LAS unsigned char*)lds_raw;
    cg::grid_group grid = cg::this_grid();
    const int tid = threadIdx.x, lane = tid & 63, wave = __builtin_amdgcn_readfirstlane(tid >> 6);
    const int G = gridDim.x, gw = blockIdx.x * NWAVES + wave, NGW = G * NWAVES;
    unsigned char* ws = a.ws;
    float* mod = (float*)(ws + WS_MOD);
    bf16_t* WinA = (bf16_t*)(ws + WS_WINA); bf16_t* WoutA = (bf16_t*)(ws + WS_WOUTA); bf16_t* WinB = (bf16_t*)(ws + WS_WINB); bf16_t* WoutB = (bf16_t*)(ws + WS_WOUTB);
    bf16_t* U = (bf16_t*)(ws + WS_U); bf16_t* ATT = (bf16_t*)(ws + WS_ATT); bf16_t* PROJ = (bf16_t*)(ws + WS_PROJ);
    int pc = 0;
#define RUN() (a.ph_lo <= pc && pc < a.ph_hi)
#define SEAM() do { if (a.ph_lo <= pc && pc + 1 < a.ph_hi) grid.sync(); ++pc; } while (0)

    if (RUN()) {
        LAS float* scr = (LAS float*)(lds + wave * 16384);
        constexpr int I_INA = 16 * (IN_A / 32), I_OUT = 16 * 32, I_INB = 16 * (IN_B / 32);
        constexpr int NITEMS = 2 * I_INA + 2 * I_OUT + 2 * I_INB + 2 * I_OUT;
        for (int it = gw; it < NITEMS; it += NGW) {
            int r = it;
            if (r < 2 * I_INA) { const int li = r / I_INA; transpose_item(a.w_in_a + (size_t)li * DM * IN_A, DM, IN_A, WinA + (size_t)li * IN_A * DM, scr, r % I_INA, lane); continue; } r -= 2 * I_INA;
            if (r < 2 * I_OUT) { const int li = r / I_OUT; transpose_item(a.w_out_a + (size_t)li * DM * DM, DM, DM, WoutA + (size_t)li * DM * DM, scr, r % I_OUT, lane); continue; } r -= 2 * I_OUT;
            if (r < 2 * I_INB) { const int li = r / I_INB; transpose_item(a.w_in_b + (size_t)li * DM * IN_B, DM, IN_B, WinB + (size_t)li * IN_B * DM, scr, r % I_INB, lane); continue; } r -= 2 * I_INB;
            { const int li = r / I_OUT; transpose_item(a.w_out_b + (size_t)li * DM * DM, DM, DM, WoutB + (size_t)li * DM * DM, scr, r % I_OUT, lane); }
        }
        __syncthreads();
        LAS float* sc = (LAS float*)lds;
        for (int item = blockIdx.x; item < 192; item += G) {
            const int l = item / 48, r = item % 48, cgp = r >> 3, ks = r & 7;
            __syncthreads();
            for (int e = tid; e < NB * 128; e += NWAVES * 64) { const int b = e >> 7, k = ks * 128 + (e & 127);
                const float cv = b < 4 ? a.c_prompt[b * DM + k] : a.c_sample[(b - 4) * DM + k]; sc[e] = silu_f(cv); }
            __syncthreads();
            const int col = cgp * 512 + tid;
            float acc[NB];
#pragma unroll
            for (int b = 0; b < NB; ++b) acc[b] = 0.f;
            const float* wp = a.w_mod + ((size_t)l * DM + ks * 128) * 3072 + col;
#pragma unroll 4
            for (int k = 0; k < 128; ++k) { const float w = wp[(size_t)k * 3072];
#pragma unroll
                for (int b = 0; b < NB; ++b) acc[b] = fmaf(sc[b * 128 + k], w, acc[b]); }
            const float bias = (ks == 0) ? a.b_mod[l * 3072 + col] : 0.f;
#pragma unroll
            for (int b = 0; b < NB; ++b) atomicAdd(mod + ((size_t)l * NB + b) * 3072 + col, acc[b] + bias);
        }
    }
    SEAM();

    if (RUN()) {
        for (int row = gw; row < NTOK; row += NGW) {
            const int b = batch_of_row(row);
            const float* xr = row < NPROMPT ? a.x_prompt + (size_t)row * DM : a.x_sample + (size_t)(row - NPROMPT) * DM;
            const float* mp = mod + (size_t)b * 3072;
#pragma unroll
            for (int j = 0; j < 4; ++j) { const int c = 4 * lane + 256 * j;
                const f32x4 xv = *(const f32x4*)(xr + c), sh = *(const f32x4*)(mp + c), scl = *(const f32x4*)(mp + 1024 + c);
                const f32x4 uv = xv * (scl + 1.f) + sh;
                u32x2 w; w.x = cvtpk(uv[0], uv[1]); w.y = cvtpk(uv[2], uv[3]);
                *(u32x2*)(U + (size_t)row * DM + c) = w; }
        }
    }
    SEAM();

#pragma unroll 1
    for (int l = 0; l < DEPTH; ++l) {
        const bool isA = (l & 1) == 0; const int li = l >> 1;
        const int nch = isA ? NCH_A : NCH_B, chrows = isA ? CH_A : CH_B, ncols = isA ? IN_A : IN_B;
        const bf16_t* Win = isA ? WinA + (size_t)li * IN_A * DM : WinB + (size_t)li * IN_B * DM;
        const bf16_t* Wout = isA ? WoutA + (size_t)li * DM * DM : WoutB + (size_t)li * DM * DM;
#pragma unroll 1
        for (int c = 0; c < nch; ++c) {
            if (RUN()) {
                pg8::Gemm g{U + (size_t)c * chrows * DM, Win, chrows, ncols, DM}; pg8::StaticOrder S; S.init(chrows, ncols, G, (int)blockIdx.x);
                pg8::EpiBf16<0> E{PROJ, ncols, nullptr, 0, 0, 1.f};
#ifndef NO_GEMM_IN
                pg8::gemm_phase<pg8::EpiBf16<0>, pg8::StaticOrder, true, true>(lds, g, S, E);
#endif
            }
            SEAM();
            if (RUN()) {
                const int row0 = c * chrows; const int S_ = row0 < NPROMPT ? 8192 : 4096;
#ifndef NO_ATT
                if (isA) attn_a_phase(PROJ, ATT + (size_t)row0 * DM, S_, lds, wave, lane);
                else attn_b_phase(PROJ, ATT + (size_t)row0 * DM, S_, a.sink_b + li * 16, lds, wave, lane);
#endif
            }
            SEAM();
        }
        if (RUN()) {
            pg8::Gemm g{ATT, Wout, NTOK, DM, DM}; pg8::StaticOrder S; S.init(NTOK, DM, G, (int)blockIdx.x);
            pg8::EpiRes E{l == 0 ? a.x_prompt : a.out, l == 0 ? a.x_sample : a.out + (size_t)NPROMPT * DM, a.out, mod + (size_t)l * NB * 3072 + 2048, 1.681792830507429f};
#ifndef NO_GEMM_OUT
            pg8::gemm_phase<pg8::EpiRes, pg8::StaticOrder, true, true>(lds, g, S, E);
#endif
        }
        SEAM();
        if (RUN()) {
            const float* gam = a.ln_g + l * DM; const float* bet = a.ln_b + l * DM;
            for (int row = gw; row < NTOK; row += NGW) {
                float* xr = a.out + (size_t)row * DM;
                f32x4 v[4]; float s = 0.f;
#pragma unroll
                for (int j = 0; j < 4; ++j) { v[j] = *(const f32x4*)(xr + 4 * lane + 256 * j); s += (v[j][0] + v[j][1]) + (v[j][2] + v[j][3]); }
                const float mean = wave_sum(s) * (1.f / DM); float s2 = 0.f;
#pragma unroll
                for (int j = 0; j < 4; ++j) { v[j] = v[j] - mean; s2 += (v[j][0] * v[j][0] + v[j][1] * v[j][1]) + (v[j][2] * v[j][2] + v[j][3] * v[j][3]); }
                const float rstd = 1.f / sqrtf(wave_sum(s2) * (1.f / DM) + LN_EPS);
                const int b = batch_of_row(row);
                const float* mp = mod + ((size_t)(l + 1) * NB + b) * 3072;
#pragma unroll
                for (int j = 0; j < 4; ++j) { const int cc = 4 * lane + 256 * j;
                    const f32x4 xo = v[j] * rstd * *(const f32x4*)(gam + cc) + *(const f32x4*)(bet + cc);
                    *(f32x4*)(xr + cc) = xo;
                    if (l + 1 < DEPTH) { const f32x4 sh = *(const f32x4*)(mp + cc), scl = *(const f32x4*)(mp + 1024 + cc); const f32x4 uv = xo * (scl + 1.f) + sh;
                        u32x2 w; w.x = cvtpk(uv[0], uv[1]); w.y = cvtpk(uv[2], uv[3]); *(u32x2*)(U + (size_t)row * DM + cc) = w; } }
            }
        }
        SEAM();
    }
#undef RUN
#undef SEAM
}

constexpr int N_PHASES = 2 + 2 * (2 * NCH_A + 2) + 2 * (2 * NCH_B + 2);
#ifndef ONE_LAUNCH
#define ONE_LAUNCH 1
#endif

extern "C" void kernel_launch(void* const* d_in, const int* in_sizes, int n_in, void* d_out, int out_size, void* d_ws, size_t ws_size, hipStream_t stream) {
    static int grid = 0;
    if (grid == 0) {
        if (n_in != 13 || out_size != NTOK * DM || ws_size < WS_END) { fprintf(stderr, "kernel_launch: unexpected shapes (n_in %d, out %d, ws %zu)\n", n_in, out_size, ws_size); grid = -1; return; }
        int dev = 0, cus = 0, per_cu = 0;
        (void)hipGetDevice(&dev); (void)hipDeviceGetAttribute(&cus, hipDeviceAttributeMultiprocessorCount, dev);
        if (hipFuncSetAttribute((const void*)mk_fwd, hipFuncAttributeMaxDynamicSharedMemorySize, LDS_BYTES) != hipSuccess) { fprintf(stderr, "kernel_launch: hipFuncSetAttribute failed\n"); grid = -1; return; }
        if (hipOccupancyMaxActiveBlocksPerMultiprocessor(&per_cu, (const void*)mk_fwd, NWAVES * 64, LDS_BYTES) != hipSuccess || per_cu < 1) per_cu = 1;
        (void)hipGetLastError();
        if (cus <= 0) cus = 256;
        grid = cus * per_cu;
    }
    if (grid < 0) return;
    (void)hipMemsetAsync((char*)d_ws + WS_MOD, 0, CTL_ZERO_BYTES, stream);
    Args a{};
    a.x_prompt = (const float*)d_in[0]; a.x_sample = (const float*)d_in[1]; a.c_prompt = (const float*)d_in[2]; a.c_sample = (const float*)d_in[3];
    a.w_mod = (const float*)d_in[4]; a.b_mod = (const float*)d_in[5]; a.ln_g = (const float*)d_in[6]; a.ln_b = (const float*)d_in[7];
    a.w_in_a = (const float*)d_in[8]; a.w_out_a = (const float*)d_in[9]; a.w_in_b = (const float*)d_in[10]; a.w_out_b = (const float*)d_in[11]; a.sink_b = (const float*)d_in[12];
    a.out = (float*)d_out; a.ws = (unsigned char*)d_ws;
#if ONE_LAUNCH
    a.ph_lo = 0; a.ph_hi = N_PHASES;
    void* params[] = {&a};
    hipError_t e = hipLaunchCooperativeKernel((const void*)mk_fwd, dim3(grid), dim3(NWAVES * 64), params, LDS_BYTES, stream);
    if (e != hipSuccess) fprintf(stderr, "kernel_launch: cooperative launch failed: %s (grid %d)\n", hipGetErrorString(e), grid);
#else
    for (int k = 0; k < N_PHASES; ++k) { a.ph_lo = k; a.ph_hi = k + 1; hipLaunchKernelGGL(mk_fwd, dim3(grid), dim3(NWAVES * 64), LDS_BYTES, stream, a); }
#endif
}
```

```cpp
#include <hip/hip_runtime.h>
#include <hip/hip_cooperative_groups.h>
#include <cstdio>
#include <cstdint>
namespace cg = cooperative_groups;
namespace pg8 {
#define PG8_LAS __attribute__((address_space(3)))
typedef unsigned short bf16_t;
typedef short bf16x8 __attribute__((ext_vector_type(8)));
typedef float f32x4 __attribute__((ext_vector_type(4)));
typedef unsigned u32x4 __attribute__((ext_vector_type(4)));
constexpr int BM = 256, BK = 64, HALF = 128, HTB = HALF * BK * 2  , STAGE_BYTES = 8 * HTB, NXCD = 8, WGM = 8;

__host__ __device__ __forceinline__ int lds_byte(int r, int c) { const int st = (r >> 4) * 2 + (c >> 5), rr = r & 15, cc = c & 31, ob = rr * 64 + cc * 2; return st * 1024 + (ob ^ (((ob >> 9) & 1) << 5)); }
__host__ __device__ __forceinline__ void stage_rc(int b, int& R, int& C) { const int st = b / 1024, sb = b % 1024, swz = sb ^ (((sb >> 9) & 1) << 5); R = (st >> 1) * 16 + swz / 64; C = (st & 1) * 32 + (swz % 64) / 2; }
__host__ __device__ __forceinline__ int perm32(int rho) { const int n = rho >> 4, i = rho & 15; return 8 * (i >> 2) + 4 * n + (i & 3); }

struct Unit { int pm, pn; };
struct Gemm { const bf16_t* A; const bf16_t* Bt; int M, N, K; };

struct StaticOrder {
    int nM, nN, nwg, G, c;
    __host__ __device__ void init(int M, int N, int G_, int c_) { nM = M / BM; nN = N / BM; nwg = nM * nN; G = G_; c = c_; }
    __host__ __device__ bool next(int i, Unit& u) const {
        const long L = (long)i * G + c; if (L >= nwg) return false;
        int wgid = (int)L; { const int q = nwg / NXCD, r = nwg % NXCD, xcd = wgid % NXCD, off = wgid / NXCD; wgid = (xcd < r ? xcd * (q + 1) : r * (q + 1) + (xcd - r) * q) + off; }
        const int nig = WGM * nN, gid = wgid / nig, fm = gid * WGM, gsz = (nM - fm) < WGM ? (nM - fm) : WGM;
        u.pm = fm + ((wgid % nig) % gsz); u.pn = (wgid % nig) / gsz; return true;
    }
    __device__ __forceinline__ void a_ready(const Unit&) const {}
    __device__ __forceinline__ void done(const Unit&) const {}
};

__device__ __forceinline__ unsigned cvt_pk_bf16(float lo, float hi) { unsigned r; asm volatile("v_cvt_pk_bf16_f32 %0, %1, %2" : "=v"(r) : "v"(lo), "v"(hi)); return r; }
typedef float f32x2 __attribute__((ext_vector_type(2)));
__device__ __forceinline__ f32x2 gelu_pk(f32x2 v) {
    const f32x2 av = __builtin_elementwise_abs(v), d = av * 0.2316418882f + 1.0f;
    f32x2 t; t.x = __builtin_amdgcn_rcpf(d.x); t.y = __builtin_amdgcn_rcpf(d.y);
    f32x2 q = t * 0.5307027145f + (-0.7265760135f); q = q * t + 0.7107068705f; q = q * t + (-0.142248368f); q = q * t + 0.127414796f; q = q * t;
    const f32x2 s = (v * v) * (-0.72134752044f);
    f32x2 e; e.x = __builtin_amdgcn_exp2f(s.x); e.y = __builtin_amdgcn_exp2f(s.y);
    const f32x2 m = v * (q * e), r = v - m;
    f32x2 o; o.x = v.x < 0.f ? m.x : r.x; o.y = v.y < 0.f ? m.y : r.y; return o;
}

template <int ACT  > struct EpiBf16 {
    static constexpr bool PERM = true, AFTER_DRAIN = false; static_assert(ACT == 0 || ACT == 1, "EpiBf16: ACT is 0 (none) or 1 (gelu_pk)");
    bf16_t* O; int ldc; const float* bias; int split_cols; size_t split_stride; float scale0;
    __device__ __forceinline__ void operator()(const f32x4 (&acc)[2][2][4][2], const Unit& u, int wr, int wc, int fr, int fq) const {
        const int row0 = u.pm * BM + wr * 64 + fr; int colt = u.pn * BM; bf16_t* base = O;
        float sc = 1.f; if (split_cols) { const int t = colt / split_cols; base += (size_t)t * split_stride; colt -= t * split_cols; if (t == 0) sc = scale0; }
        const int col0 = colt + wc * 32 + 8 * fq, bcol0 = u.pn * BM + wc * 32 + 8 * fq;
        f32x4 bv[2][2];
#pragma unroll
        for (int bj = 0; bj < 2; ++bj)
#pragma unroll
            for (int n = 0; n < 2; ++n) bv[bj][n] = bias ? *(const f32x4*)(bias + bcol0 + bj * HALF + 4 * n) : (f32x4){0.f, 0.f, 0.f, 0.f};
#pragma unroll
        for (int ai = 0; ai < 2; ++ai)
#pragma unroll
            for (int m = 0; m < 4; ++m) { bf16_t* rowp = base + (size_t)(row0 + ai * HALF + m * 16) * ldc + col0;
#pragma unroll
                for (int bj = 0; bj < 2; ++bj) { f32x4 v0 = acc[ai][bj][m][0] + bv[bj][0], v1 = acc[ai][bj][m][1] + bv[bj][1];
                    if (ACT == 1) { f32x2 a = gelu_pk((f32x2){v0[0], v0[1]}), b = gelu_pk((f32x2){v0[2], v0[3]}), c = gelu_pk((f32x2){v1[0], v1[1]}), d = gelu_pk((f32x2){v1[2], v1[3]});
                        v0 = (f32x4){a.x, a.y, b.x, b.y}; v1 = (f32x4){c.x, c.y, d.x, d.y}; }
                    v0 = v0 * sc; v1 = v1 * sc; u32x4 w; w.x = cvt_pk_bf16(v0[0], v0[1]); w.y = cvt_pk_bf16(v0[2], v0[3]); w.z = cvt_pk_bf16(v1[0], v1[1]); w.w = cvt_pk_bf16(v1[2], v1[3]);
                    *(u32x4*)(rowp + bj * HALF) = w; } }
    }
};
struct EpiRes {
    static constexpr bool PERM = false, AFTER_DRAIN = false;
    const float* xa; const float* xb; float* out; const float* gate_base; float alpha;
    __device__ __forceinline__ void operator()(const f32x4 (&acc)[2][2][4][2], const Unit& u, int wr, int wc, int fr, int fq) const {
        const int rowt = u.pm * BM;
        const int b = rowt < 32768 ? (rowt >> 13) : 4 + ((rowt - 32768) >> 12);
        const float* xs = rowt < 32768 ? xa + (size_t)rowt * 1024 : xb + (size_t)(rowt - 32768) * 1024;
        float* os = out + (size_t)rowt * 1024;
        const float* gp = gate_base + b * 3072;
        const int col0 = u.pn * BM + wc * 32 + 4 * fq;
        f32x4 gv[2][2];
#pragma unroll
        for (int bj = 0; bj < 2; ++bj)
#pragma unroll
            for (int n = 0; n < 2; ++n) gv[bj][n] = *(const f32x4*)(gp + col0 + bj * HALF + n * 16);
#pragma unroll
        for (int ai = 0; ai < 2; ++ai)
#pragma unroll
            for (int m = 0; m < 4; ++m) { const size_t off = (size_t)(wr * 64 + fr + ai * HALF + m * 16) * 1024 + col0;
#pragma unroll
                for (int bj = 0; bj < 2; ++bj)
#pragma unroll
                    for (int n = 0; n < 2; ++n) { const f32x4 xv = *(const f32x4*)(xs + off + bj * HALF + n * 16);
                        *(f32x4*)(os + off + bj * HALF + n * 16) = xv * alpha + gv[bj][n] * acc[ai][bj][m][n]; } }
    }
};
template <class Epi, class Sched, bool ALIGN_EPI = false, bool SP2 = false>
__device__ __forceinline__ void gemm_phase(PG8_LAS unsigned char* lds, const Gemm g, const Sched& S, const Epi& E) {
    int tid_l = threadIdx.x; asm volatile("" : "+v"(tid_l));
    const int tid = tid_l, wid = __builtin_amdgcn_readfirstlane(tid >> 6), lane = tid & 63, wr = wid >> 2, wc = wid & 3, fr = lane & 15, fq = lane >> 4;
    const int K = g.K, nt = K / BK;
    unsigned voffA[2], voffB[2];
#pragma unroll
    for (int i = 0; i < 2; ++i) { int R, C; stage_rc(tid * 16 + i * 8192, R, C); const int Rb = Epi::PERM ? ((R & ~31) + perm32(R & 31)) : R;
        voffA[i] = (unsigned)(R * K + C) * 2u; voffB[i] = (unsigned)(Rb * K + C) * 2u; }
    const size_t kstep = (size_t)(BK * 2);
    const size_t hstep = (size_t)HALF * K * 2;
    const size_t tstep = 2 * hstep;
    const unsigned ldsw = (unsigned)wid * 1024u;
    const int aoff = lds_byte(wr * 64 + fr, fq * 8), boff = lds_byte(wc * 32 + fr, fq * 8);
#define PG8_SA(b, h) (((b) * 2 + (h)) * HTB)
#define PG8_SB(b, h) ((4 + (b) * 2 + (h)) * HTB)
#define PG8_STAGE(bufoff, gbase, voff) do { _Pragma("unroll") for (int _i = 0; _i < 2; ++_i) \
        __builtin_amdgcn_global_load_lds((const unsigned*)((const char*)(gbase) + (voff)[_i]), (PG8_LAS unsigned*)(lds + (bufoff) + ldsw + _i * 8192), 16, 0, 0); } while (0)
#define PG8_LDA(dst, b, h) do { _Pragma("unroll") for (int m = 0; m < 4; ++m) _Pragma("unroll") for (int k = 0; k < 2; ++k) dst[m][k] = *(const PG8_LAS bf16x8*)(lds + PG8_SA(b, h) + aoff + m * 2048 + k * 1024); } while (0)
#define PG8_LDB(dst, b, h) do { _Pragma("unroll") for (int n = 0; n < 2; ++n) _Pragma("unroll") for (int k = 0; k < 2; ++k) dst[n][k] = *(const PG8_LAS bf16x8*)(lds + PG8_SB(b, h) + boff + n * 2048 + k * 1024); } while (0)
#define PG8_MMA(ai, bj, At, Bt) do { __builtin_amdgcn_s_setprio(1); _Pragma("unroll") for (int m = 0; m < 4; ++m) _Pragma("unroll") for (int n = 0; n < 2; ++n) _Pragma("unroll") for (int k = 0; k < 2; ++k) \
        acc[ai][bj][m][n] = __builtin_amdgcn_mfma_f32_16x16x32_bf16(Bt[n][k], At[m][k], acc[ai][bj][m][n], 0, 0, 0); __builtin_amdgcn_s_setprio(0); } while (0)
#define PG8_WAIT_V(n) asm volatile("s_waitcnt vmcnt(" #n ")" ::: "memory")
#define PG8_WAIT_L(n) asm volatile("s_waitcnt lgkmcnt(" #n ")" ::: "memory")
#define PG8_BAR __builtin_amdgcn_s_barrier()
#define PG8_SCHED __builtin_amdgcn_sched_barrier(0)
    Unit cur, nxt; int ui = 0;
    if (!S.next(0, cur)) return;
    f32x4 acc[2][2][4][2];
#pragma unroll
    for (int a = 0; a < 2; ++a)
#pragma unroll
        for (int b = 0; b < 2; ++b)
#pragma unroll
            for (int m = 0; m < 4; ++m)
#pragma unroll
                for (int n = 0; n < 2; ++n) acc[a][b][m][n] = (f32x4){0.f, 0.f, 0.f, 0.f};
    bf16x8 At[4][2], B0[2][2], B1[2][2];
    const char* cA = (const char*)g.A + (size_t)cur.pm * tstep; const char* cB = (const char*)g.Bt + (size_t)cur.pn * tstep;
    S.a_ready(cur);
    if constexpr (SP2) {
        PG8_STAGE(PG8_SB(0, 0), cB, voffB); PG8_STAGE(PG8_SB(0, 1), cB + hstep, voffB); PG8_STAGE(PG8_SA(0, 0), cA, voffA); PG8_STAGE(PG8_SA(0, 1), cA + hstep, voffA);
        if (wr == 1) PG8_BAR;
        PG8_WAIT_V(2); PG8_BAR;
        PG8_STAGE(PG8_SB(1, 0), cB + kstep, voffB); PG8_STAGE(PG8_SA(1, 0), cA + kstep, voffA); PG8_STAGE(PG8_SB(1, 1), cB + hstep + kstep, voffB);
        PG8_WAIT_V(6); PG8_BAR;
    } else {
        PG8_STAGE(PG8_SB(0, 0), cB, voffB); PG8_STAGE(PG8_SA(0, 0), cA, voffA); PG8_STAGE(PG8_SB(0, 1), cB + hstep, voffB); PG8_STAGE(PG8_SA(0, 1), cA + hstep, voffA);
        if (wr == 1) PG8_BAR;
        PG8_WAIT_V(4); PG8_BAR;
        PG8_STAGE(PG8_SB(1, 0), cB + kstep, voffB); PG8_STAGE(PG8_SA(1, 0), cA + kstep, voffA); PG8_STAGE(PG8_SB(1, 1), cB + hstep + kstep, voffB);
        PG8_WAIT_V(6); PG8_BAR;
    }
    for (;;) {
        const bool has_next = S.next(ui + 1, nxt);
        const char* nA = has_next ? (const char*)g.A + (size_t)nxt.pm * tstep : cA; const char* nB = has_next ? (const char*)g.Bt + (size_t)nxt.pn * tstep : cB;
        for (int t = 0; t < nt; t += 2) {
            const bool last = (t == nt - 2);
            const char* a1 = cA + (size_t)(t + 1) * kstep;
            const char* a2 = last ? nA : cA + (size_t)(t + 2) * kstep; const char* b2 = last ? nB : cB + (size_t)(t + 2) * kstep;
            const char* a3 = a2 + kstep; const char* b3 = b2 + kstep;
            if (last && has_next) S.a_ready(nxt);
            if constexpr (SP2) {
            PG8_LDB(B0, 0, 0); PG8_LDB(B1, 0, 1); PG8_SCHED; PG8_LDA(At, 0, 0); PG8_STAGE(PG8_SA(1, 1), a1 + hstep, voffA);
            PG8_WAIT_V(8); PG8_WAIT_L(0); PG8_BAR; PG8_MMA(0, 0, At, B0); PG8_MMA(0, 1, At, B1); PG8_BAR; PG8_SCHED;
            PG8_LDA(At, 0, 1); PG8_STAGE(PG8_SB(0, 0), b2, voffB); PG8_STAGE(PG8_SB(0, 1), b2 + hstep, voffB); PG8_STAGE(PG8_SA(0, 0), a2, voffA);
            PG8_WAIT_V(8); PG8_WAIT_L(0); PG8_BAR; PG8_MMA(1, 0, At, B0); PG8_MMA(1, 1, At, B1); PG8_BAR; PG8_SCHED;
            PG8_LDB(B0, 1, 0); PG8_LDB(B1, 1, 1); PG8_SCHED; PG8_LDA(At, 1, 0); PG8_STAGE(PG8_SA(0, 1), a2 + hstep, voffA);
            PG8_WAIT_V(8); PG8_WAIT_L(0); PG8_BAR; PG8_MMA(0, 0, At, B0); PG8_MMA(0, 1, At, B1); PG8_BAR; PG8_SCHED;
            PG8_LDA(At, 1, 1); PG8_STAGE(PG8_SB(1, 0), b3, voffB); PG8_STAGE(PG8_SB(1, 1), b3 + hstep, voffB); PG8_STAGE(PG8_SA(1, 0), a3, voffA);
            PG8_WAIT_V(8); PG8_WAIT_L(0); PG8_BAR; PG8_MMA(1, 0, At, B0); PG8_MMA(1, 1, At, B1); PG8_BAR; PG8_SCHED;
            } else {
            PG8_LDB(B0, 0, 0); PG8_SCHED; PG8_LDA(At, 0, 0); PG8_STAGE(PG8_SA(1, 1), a1 + hstep, voffA);
            PG8_WAIT_L(8); PG8_BAR; PG8_WAIT_L(0); PG8_MMA(0, 0, At, B0); PG8_BAR; PG8_SCHED;
            PG8_LDB(B1, 0, 1); PG8_STAGE(PG8_SB(0, 0), b2, voffB);
            PG8_BAR; PG8_WAIT_L(0); PG8_MMA(0, 1, At, B1); PG8_BAR;
            PG8_LDA(At, 0, 1); PG8_STAGE(PG8_SA(0, 0), a2, voffA);
            PG8_BAR; PG8_WAIT_L(0); PG8_MMA(1, 0, At, B0); PG8_BAR; PG8_SCHED;
            PG8_STAGE(PG8_SB(0, 1), b2 + hstep, voffB);
            PG8_WAIT_V(6); PG8_BAR; PG8_MMA(1, 1, At, B1); PG8_BAR;
            PG8_LDB(B0, 1, 0); PG8_SCHED; PG8_LDA(At, 1, 0); PG8_STAGE(PG8_SA(0, 1), a2 + hstep, voffA);
            PG8_WAIT_L(8); PG8_BAR; PG8_WAIT_L(0); PG8_MMA(0, 0, At, B0); PG8_BAR; PG8_SCHED;
            PG8_LDB(B1, 1, 1); PG8_STAGE(PG8_SB(1, 0), b3, voffB);
            PG8_BAR; PG8_WAIT_L(0); PG8_MMA(0, 1, At, B1); PG8_BAR;
            PG8_LDA(At, 1, 1); PG8_STAGE(PG8_SA(1, 0), a3, voffA);
            PG8_BAR; PG8_WAIT_L(0); PG8_MMA(1, 0, At, B0); PG8_BAR; PG8_SCHED;
            PG8_STAGE(PG8_SB(1, 1), b3 + hstep, voffB);
            PG8_WAIT_V(6); PG8_BAR; PG8_MMA(1, 1, At, B1); PG8_BAR;
            }
        }
        if constexpr (ALIGN_EPI) { if (wr == 0) PG8_BAR; }
        if constexpr (!Epi::AFTER_DRAIN) { E(acc, cur, wr, wc, fr, fq); S.done(cur); }
        if (!has_next) break;
#pragma unroll
        for (int a = 0; a < 2; ++a)
#pragma unroll
            for (int b = 0; b < 2; ++b)
#pragma unroll
                for (int m = 0; m < 4; ++m)
#pragma unroll
                    for (int n = 0; n < 2; ++n) acc[a][b][m][n] = (f32x4){0.f, 0.f, 0.f, 0.f};
        cur = nxt; cA = nA; cB = nB; ++ui;
        if constexpr (ALIGN_EPI) { if (wr == 1) PG8_BAR; }
    }
    PG8_WAIT_V(0);
    if constexpr (!ALIGN_EPI) { if (wr == 0) PG8_BAR; }
    PG8_BAR;
    if constexpr (Epi::AFTER_DRAIN) { E.fused(acc, cur, wr, wc, fr, fq, lds, wid, lane); S.done(cur); }
#undef PG8_SA
#undef PG8_SB
#undef PG8_STAGE
#undef PG8_LDA
#undef PG8_LDB
#undef PG8_MMA
#undef PG8_WAIT_V
#undef PG8_WAIT_L
#undef PG8_BAR
#undef PG8_SCHED
}
}
constexpr int DM = 1024, NTOK = 65536, NPROMPT = 32768, NB = 12, DEPTH = 4;
constexpr int IN_A = 10240, IN_B = 2560;
constexpr int CH_A = 8192, NCH_A = 8, CH_B = 32768, NCH_B = 2;
constexpr float LN_EPS = 1e-5f;
constexpr float LOG2E = 1.4426950408889634f;
constexpr float CSCALE = 0.125f * LOG2E;
constexpr size_t MiB = 1u << 20;
constexpr size_t WS_MOD = 0, CTL_ZERO_BYTES = 1 * MiB;
constexpr size_t WS_BAR = 640 * 1024;
constexpr size_t WS_WINA = 2 * MiB;
constexpr size_t WS_WOUTA = 42 * MiB;
constexpr size_t WS_WINB = 46 * MiB;
constexpr size_t WS_WOUTB = 56 * MiB;
constexpr size_t WS_U = 64 * MiB;
constexpr size_t WS_ATT = 192 * MiB;
constexpr size_t WS_PROJ = 320 * MiB;
constexpr size_t WS_END = 480 * MiB;
constexpr int LDS_BYTES = 147456;
constexpr int NWAVES = 8;

#define LAS __attribute__((address_space(3)))
typedef unsigned short bf16_t;
typedef short bf16x8 __attribute__((ext_vector_type(8)));
typedef short s16x4 __attribute__((ext_vector_type(4)));
typedef float f32x4 __attribute__((ext_vector_type(4)));
typedef float f32x2 __attribute__((ext_vector_type(2)));
typedef unsigned u32x4 __attribute__((ext_vector_type(4)));
typedef unsigned u32x2 __attribute__((ext_vector_type(2)));
typedef __bf16 bf16x2_t __attribute__((ext_vector_type(2)));
typedef short v4i16_t __attribute__((ext_vector_type(4)));

__device__ __forceinline__ unsigned cvtpk(float lo, float hi) { f32x2 v = {lo, hi}; bf16x2_t b = __builtin_convertvector(v, bf16x2_t); return __builtin_bit_cast(unsigned, b); }
__device__ __forceinline__ float bf_lo(unsigned w) { return __uint_as_float(w << 16); }
__device__ __forceinline__ float bf_hi(unsigned w) { return __uint_as_float(w & 0xffff0000u); }
__device__ __forceinline__ float silu_f(float z) { return z / (1.f + __expf(-z)); }
__device__ __forceinline__ int batch_of_row(int row) { return row < NPROMPT ? (row >> 13) : 4 + ((row - NPROMPT) >> 12); }
__device__ __forceinline__ float wave_sum(float v) {
#pragma unroll
    for (int o = 1; o < 64; o <<= 1) v += __shfl_xor(v, o);
    return v;
}

#define XB_TMO      128
#define XB_XCNT(j)  (256  + 64 * (j))
#define XB_XSUB(j)  (1280 + 64 * (j))
#define XB_XGEN(j)  (2304 + 64 * (j))
#define XB_TOP      3328
#define XB_TOPGEN   3392
#define XCD_BAR_WORDS 3456
#define XB_SPIN_CAP (1u << 18)

__device__ __forceinline__ unsigned xb_ld(unsigned* p)              { return __hip_atomic_load(p, __ATOMIC_RELAXED, __HIP_MEMORY_SCOPE_AGENT); }
__device__ __forceinline__ unsigned xb_add(unsigned* p, unsigned v) { return __hip_atomic_fetch_add(p, v, __ATOMIC_RELAXED, __HIP_MEMORY_SCOPE_AGENT); }
__device__ __forceinline__ unsigned xb_xcc_id() { return (unsigned)__builtin_amdgcn_s_getreg((3 << 11) | 20) & 0xFu; }
#define XB_SPIN(cond, bar) do { unsigned _sp = 0; while (cond) { __builtin_amdgcn_s_sleep(1); \
    if ((++_sp & 255u) == 0u) { if (xb_ld(&(bar)[XB_TMO])) break; if (_sp > XB_SPIN_CAP) { atomicAdd(&(bar)[XB_TMO], 1u); break; } } } } while (0)

struct XcdBarrier {
    unsigned* bar; unsigned x;
    volatile LAS unsigned* st;
};

__device__ __forceinline__ XcdBarrier xcd_barrier_post(unsigned* bar, volatile LAS unsigned* st) {
    XcdBarrier b; b.bar = bar; b.x = xb_xcc_id(); b.st = st;
    if (threadIdx.x == 0) (void)xb_add(&bar[XB_XCNT(b.x)], 1u);
    return b;
}
__device__ __forceinline__ void xcd_barrier_complete(unsigned* bar, unsigned x, unsigned& nloc, unsigned& nx) {
    const unsigned G = gridDim.x * gridDim.y * gridDim.z;
    unsigned sum, cnt, mine, sp = 0u;
    for (;;) {
        sum = 0u; cnt = 0u; mine = 0u;
#pragma unroll
        for (unsigned j = 0; j < 16; ++j) { const unsigned c = xb_ld(&bar[XB_XCNT(j)]); sum += c; cnt += (c > 0u) ? 1u : 0u; mine = (j == x) ? c : mine; }
        if (sum == G) break;
        __builtin_amdgcn_s_sleep(1);
        if ((++sp & 255u) == 0u) { if (xb_ld(&bar[XB_TMO])) break; if (sp > XB_SPIN_CAP) { atomicAdd(&bar[XB_TMO], 1u); break; } }
    }
    nloc = mine > 0u ? mine : 1u; nx = cnt > 0u ? cnt : 1u;
}

__device__ __forceinline__ void xcd_barrier(const XcdBarrier& b) {
    asm volatile("s_waitcnt vmcnt(0)" ::: "memory");
    __syncthreads();
    if (threadIdx.x == 0) {
        unsigned* bar = b.bar;
        __builtin_amdgcn_s_waitcnt(0);
        unsigned nloc = b.st[0], nx = b.st[1];
        if (nloc == 0u) { xcd_barrier_complete(bar, b.x, nloc, nx); b.st[0] = nloc; b.st[1] = nx; }
        const unsigned old = xb_add(&bar[XB_XSUB(b.x)], 1u);
        const unsigned gen = old / nloc;
        if (old + 1u == (gen + 1u) * nloc) {
            __builtin_amdgcn_fence(__ATOMIC_RELEASE, "agent");
            asm volatile("s_waitcnt vmcnt(0)" ::: "memory");
            const unsigned og = xb_add(&bar[XB_TOP], 1u);
            const unsigned tg = og / nx;
            if (og + 1u == (tg + 1u) * nx) xb_add(&bar[XB_TOPGEN], 1u);
            else XB_SPIN(xb_ld(&bar[XB_TOPGEN]) == tg, bar);
            __builtin_amdgcn_fence(__ATOMIC_ACQUIRE, "agent");
            xb_add(&bar[XB_XGEN(b.x)], 1u);
            asm volatile("s_waitcnt vmcnt(0)" ::: "memory");
        } else {
            XB_SPIN(xb_ld(&bar[XB_XGEN(b.x)]) == gen, bar);
            __builtin_amdgcn_fence(__ATOMIC_ACQUIRE, "agent");
            asm volatile("s_waitcnt vmcnt(0)" ::: "memory");
        }
    }
    __syncthreads();
}

template <int D_, int NS, int QSTEP, int NSTEPS>
__device__ __forceinline__ void group_pass(const bf16_t* __restrict__ Pq, const bf16_t* __restrict__ Pk, const bf16_t* __restrict__ Pv, int pitch, int S, int t0, int tq,
                                           float slope2, LAS unsigned char* vl, int lane, float& m, float& l, f32x4 (&o)[4]) {
    const int i = lane & 15, g = lane >> 4;
    bf16x8 qb[2];
#pragma unroll
    for (int s = 0; s < 2; ++s) qb[s] = *(const bf16x8*)(Pq + (size_t)tq * pitch + 8 * g + 32 * s);
    const float relbase = (float)(-NS + 4 * g - QSTEP * i);
    const int lo_i = -(tq / D_), hi_i = (S - 1 - tq) / D_;
    const float lo = (float)(lo_i > -NS ? lo_i : -NS), hi = (float)(hi_i < NS ? hi_i : NS);
    const int vk = lane >> 3, vc = lane & 7;
    const bf16_t* kp = Pk + 8 * g;
    const bf16_t* vp = Pv + 8 * vc;
    LAS unsigned char* vw = vl + vk * 160 + vc * 16;
    LAS unsigned char* vb = vl + (4 * g + ((lane & 15) >> 2)) * 160 + 8 * (lane & 3);
    bf16x8 kn[2][2]; u32x4 vn[4];
#define ATT_LOAD(st_) do { \
        _Pragma("unroll") for (int t_ = 0; t_ < 2; ++t_) { int tk = t0 + D_ * (32 * (st_) + 16 * t_ + i - NS); tk = tk < 0 ? 0 : (tk > S - 1 ? S - 1 : tk); \
            _Pragma("unroll") for (int s = 0; s < 2; ++s) kn[t_][s] = *(const bf16x8*)(kp + (size_t)tk * pitch + 32 * s); } \
        _Pragma("unroll") for (int c = 0; c < 4; ++c) { int tk = t0 + D_ * (32 * (st_) + 8 * c + vk - NS); tk = tk < 0 ? 0 : (tk > S - 1 ? S - 1 : tk); \
            vn[c] = *(const u32x4*)(vp + (size_t)tk * pitch); } } while (0)
    ATT_LOAD(0);
#pragma unroll 1
    for (int st = 0; st < NSTEPS; ++st) {
        bf16x8 kc[2][2]; u32x4 vcur[4];
#pragma unroll
        for (int t_ = 0; t_ < 2; ++t_)
#pragma unroll
            for (int s = 0; s < 2; ++s) kc[t_][s] = kn[t_][s];
#pragma unroll
        for (int c = 0; c < 4; ++c) vcur[c] = vn[c];
        if (st + 1 < NSTEPS) ATT_LOAD(st + 1);
#pragma unroll
        for (int c = 0; c < 4; ++c) *(LAS u32x4*)(vw + c * 1280) = vcur[c];
        f32x4 sa[2];
#pragma unroll
        for (int t_ = 0; t_ < 2; ++t_) {
            sa[t_] = __builtin_amdgcn_mfma_f32_16x16x32_bf16(kc[t_][0], qb[0], (f32x4){0.f, 0.f, 0.f, 0.f}, 0, 0, 0);
            sa[t_] = __builtin_amdgcn_mfma_f32_16x16x32_bf16(kc[t_][1], qb[1], sa[t_], 0, 0, 0);
        }
        const float rb = relbase + (float)(32 * st);
        float sc[8];
#pragma unroll
        for (int t_ = 0; t_ < 2; ++t_)
#pragma unroll
            for (int r = 0; r < 4; ++r) {
                const float relf = rb + (float)(16 * t_ + r);
                const float v = fmaf(-slope2, fabsf(relf), sa[t_][r] * CSCALE);
                sc[4 * t_ + r] = (relf >= lo && relf <= hi) ? v : -1e30f;
            }
        float mx = fmaxf(fmaxf(fmaxf(sc[0], sc[1]), fmaxf(sc[2], sc[3])), fmaxf(fmaxf(sc[4], sc[5]), fmaxf(sc[6], sc[7])));
        mx = fmaxf(mx, __shfl_xor(mx, 16)); mx = fmaxf(mx, __shfl_xor(mx, 32));
        const float mn = fmaxf(m, mx), alpha = __builtin_amdgcn_exp2f(m - mn); m = mn;
        float ps = 0.f;
#pragma unroll
        for (int k = 0; k < 8; ++k) { sc[k] = __builtin_amdgcn_exp2f(sc[k] - mn); ps += sc[k]; }
        l = l * alpha + ps;
#pragma unroll
        for (int n = 0; n < 4; ++n) o[n] = o[n] * alpha;
        u32x4 pw; pw.x = cvtpk(sc[0], sc[1]); pw.y = cvtpk(sc[2], sc[3]); pw.z = cvtpk(sc[4], sc[5]); pw.w = cvtpk(sc[6], sc[7]);
        const bf16x8 pb = __builtin_bit_cast(bf16x8, pw);
#pragma unroll
        for (int n = 0; n < 4; ++n) {
            const s16x4 v0 = __builtin_bit_cast(s16x4, __builtin_amdgcn_ds_read_tr16_b64_v4i16((LAS v4i16_t*)(vb + n * 32)));
            const s16x4 v1 = __builtin_bit_cast(s16x4, __builtin_amdgcn_ds_read_tr16_b64_v4i16((LAS v4i16_t*)(vb + n * 32 + 2560)));
            const bf16x8 va = (bf16x8){v0[0], v0[1], v0[2], v0[3], v1[0], v1[1], v1[2], v1[3]};
            o[n] = __builtin_amdgcn_mfma_f32_16x16x32_bf16(va, pb, o[n], 0, 0, 0);
        }
    }
#undef ATT_LOAD
}

__device__ __forceinline__ void attn_store(const bf16_t* __restrict__ Pz, int pitch, int tq, bf16_t* __restrict__ orow0  , int lane, float l, const f32x4 (&o)[4]) {
    const int g = lane >> 4;
    float lt = l + __shfl_xor(l, 16); lt = lt + __shfl_xor(lt, 32);
    const float inv = 1.f / lt;
#pragma unroll
    for (int n = 0; n < 4; ++n) {
        const u32x2 zw = *(const u32x2*)(Pz + (size_t)tq * pitch + 16 * n + 4 * g);
        const float a0 = o[n][0] * inv * silu_f(bf_lo(zw.x)), a1 = o[n][1] * inv * silu_f(bf_hi(zw.x));
        const float a2 = o[n][2] * inv * silu_f(bf_lo(zw.y)), a3 = o[n][3] * inv * silu_f(bf_hi(zw.y));
        u32x2 w; w.x = cvtpk(a0, a1); w.y = cvtpk(a2, a3);
        *(u32x2*)(orow0 + (size_t)tq * 1024 + 16 * n + 4 * g) = w;
    }
}

__device__ __forceinline__ void attn_a_phase(const bf16_t* P, bf16_t* A, int S, LAS unsigned char* lds, int wave, int lane_in) {
    int lane = lane_in; asm volatile("" : "+v"(lane));
    LAS unsigned char* vl = lds + wave * 5120;
    for (int bu = blockIdx.x; bu < 256; bu += gridDim.x) {
        const int tile = bu >> 3, hp = bu & 7;
#pragma unroll 1
        for (int it = 0; it < 4; ++it) {
            const int idx = it * 8 + wave, h = 2 * hp + (idx >> 4), res = idx & 15;
            const int tc = tile * 256 + res, seq0 = (tc / S) * S, t0 = tc - seq0, tq = t0 + 16 * (lane & 15);
            const bf16_t* Ps = P + (size_t)seq0 * IN_A + h * 64;
            const float slope = __builtin_amdgcn_exp2f(-0.5f * (float)(h + 1)) * LOG2E;
            float m = -1e30f, l = 0.f; f32x4 o[4];
#pragma unroll
            for (int n = 0; n < 4; ++n) o[n] = (f32x4){0.f, 0.f, 0.f, 0.f};
            group_pass<1, 64, 16, 12>(Ps, Ps + 1024, Ps + 2048, IN_A, S, t0, tq, slope, vl, lane, m, l, o);
            group_pass<4, 64, 4, 6>(Ps + 3072, Ps + 4096, Ps + 5120, IN_A, S, t0, tq, slope * 4.f, vl, lane, m, l, o);
            group_pass<16, 64, 1, 5>(Ps + 6144, Ps + 7168, Ps + 8192, IN_A, S, t0, tq, slope * 16.f, vl, lane, m, l, o);
            attn_store(Ps + 9216, IN_A, tq, A + (size_t)seq0 * 1024 + h * 64, lane, l, o);
        }
    }
}
__device__ __forceinline__ void attn_b_phase(const bf16_t* P, bf16_t* A, int S, const float* sink, LAS unsigned char* lds, int wave, int lane_in) {
    int lane = lane_in; asm volatile("" : "+v"(lane));
    LAS unsigned char* vl = lds + wave * 5120;
    for (int bu = blockIdx.x; bu < 256; bu += gridDim.x) {
        const int tile = bu >> 1, hh = bu & 1;
#pragma unroll 1
        for (int it = 0; it < 16; ++it) {
            const int idx = it * 8 + wave, h = 8 * hh + (idx >> 4), sub = idx & 15;
            const int tc = tile * 256 + 16 * sub, seq0 = (tc / S) * S, t0 = tc - seq0, tq = t0 + (lane & 15);
            const bf16_t* Ps = P + (size_t)seq0 * IN_B;
            const float slope = __builtin_amdgcn_exp2f(-0.5f * (float)(h + 1)) * LOG2E;
            float m = sink[h] * LOG2E, l = (lane < 16) ? 1.f : 0.f; f32x4 o[4];
#pragma unroll
            for (int n = 0; n < 4; ++n) o[n] = (f32x4){0.f, 0.f, 0.f, 0.f};
            group_pass<1, 128, 1, 9>(Ps + h * 64, Ps + 1024 + (h >> 2) * 64, Ps + 1280 + (h >> 2) * 64, IN_B, S, t0, tq, slope, vl, lane, m, l, o);
            attn_store(Ps + 1536 + h * 64, IN_B, tq, A + (size_t)seq0 * 1024 + h * 64, lane, l, o);
        }
    }
}

__device__ __forceinline__ unsigned f2bf(float f) { unsigned u = __builtin_bit_cast(unsigned, f); return (u + 0x7fffu + ((u >> 16) & 1u)) >> 16; }
__device__ __forceinline__ unsigned pk2(float lo, float hi) { return f2bf(lo) | (f2bf(hi) << 16); }
__device__ __forceinline__ void transpose_item(const float* __restrict__ W, int K, int N, bf16_t* __restrict__ WT, LAS float* scr, int item, int lane) {
    const int nblk = N / 32, kb = item / nblk, nb = item % nblk, k0 = 64 * kb, n0 = 32 * nb;
#pragma unroll 8
    for (int i = 0; i < 32; ++i) { const int kk = 2 * i + (lane >> 5); scr[kk * 33 + (lane & 31)] = W[(size_t)(k0 + kk) * N + n0 + (lane & 31)]; }
    asm volatile("s_waitcnt lgkmcnt(0)" ::: "memory");
    const int c = lane & 7;
#pragma unroll
    for (int j = 0; j < 4; ++j) { const int n = (lane >> 3) + 8 * j; const LAS float* s = scr + (8 * c) * 33 + n;
        u32x4 o; o.x = pk2(s[0 * 33], s[1 * 33]); o.y = pk2(s[2 * 33], s[3 * 33]); o.z = pk2(s[4 * 33], s[5 * 33]); o.w = pk2(s[6 * 33], s[7 * 33]);
        *(u32x4*)(WT + (size_t)(n0 + n) * K + k0 + 8 * c) = o; }
    asm volatile("s_waitcnt lgkmcnt(0)" ::: "memory");
}

struct Args {
    const float *x_prompt, *x_sample, *c_prompt, *c_sample, *w_mod, *b_mod, *ln_g, *ln_b, *w_in_a, *w_out_a, *w_in_b, *w_out_b, *sink_b;
    float* out; unsigned char* ws; int ph_lo, ph_hi;
};

__global__ void __launch_bounds__(NWAVES * 64, 2) mk_fwd(Args a) {
    extern __shared__ __attribute__((aligned(16))) unsigned char lds_raw[];
    LAS unsigned char* lds = (LAS unsigned char*)lds_raw;
    cg::grid_group grid = cg::this_grid();
    const int tid = threadIdx.x, lane = tid & 63, wave = __builtin_amdgcn_readfirstlane(tid >> 6);
    const int G = gridDim.x, gw = blockIdx.x * NWAVES + wave, NGW = G * NWAVES;
    unsigned char* ws = a.ws;
    float* mod = (float*)(ws + WS_MOD);
    bf16_t* WinA = (bf16_t*)(ws + WS_WINA); bf16_t* WoutA = (bf16_t*)(ws + WS_WOUTA); bf16_t* WinB = (bf16_t*)(ws + WS_WINB); bf16_t* WoutB = (bf16_t*)(ws + WS_WOUTB);
    bf16_t* U = (bf16_t*)(ws + WS_U); bf16_t* ATT = (bf16_t*)(ws + WS_ATT); bf16_t* PROJ = (bf16_t*)(ws + WS_PROJ);
    volatile LAS unsigned* bst = (volatile LAS unsigned*)(lds + 131072 + 64);
    if (tid < 2) bst[tid] = 0u;
    __syncthreads();
    XcdBarrier bar; bar.bar = (unsigned*)(ws + WS_BAR); bar.x = 0; bar.st = bst;
    if (a.ph_hi - a.ph_lo > 1) bar = xcd_barrier_post((unsigned*)(ws + WS_BAR), bst);
    int pc = 0;
#define RUN() (a.ph_lo <= pc && pc < a.ph_hi)
#define SEAM() do { if (a.ph_lo <= pc && pc + 1 < a.ph_hi) { if (pc == 0) grid.sync(); else xcd_barrier(bar); } ++pc; } while (0)

    if (RUN()) {
        LAS float* scr = (LAS float*)(lds + wave * 16384);
        constexpr int I_INA = 16 * (IN_A / 32), I_OUT = 16 * 32, I_INB = 16 * (IN_B / 32);
        constexpr int NITEMS = 2 * I_INA + 2 * I_OUT + 2 * I_INB + 2 * I_OUT;
        for (int it = gw; it < NITEMS; it += NGW) {
            int r = it;
            if (r < 2 * I_INA) { const int li = r / I_INA; transpose_item(a.w_in_a + (size_t)li * DM * IN_A, DM, IN_A, WinA + (size_t)li * IN_A * DM, scr, r % I_INA, lane); continue; } r -= 2 * I_INA;
            if (r < 2 * I_OUT) { const int li = r / I_OUT; transpose_item(a.w_out_a + (size_t)li * DM * DM, DM, DM, WoutA + (size_t)li * DM * DM, scr, r % I_OUT, lane); continue; } r -= 2 * I_OUT;
            if (r < 2 * I_INB) { const int li = r / I_INB; transpose_item(a.w_in_b + (size_t)li * DM * IN_B, DM, IN_B, WinB + (size_t)li * IN_B * DM, scr, r % I_INB, lane); continue; } r -= 2 * I_INB;
            { const int li = r / I_OUT; transpose_item(a.w_out_b + (size_t)li * DM * DM, DM, DM, WoutB + (size_t)li * DM * DM, scr, r % I_OUT, lane); }
        }
        __syncthreads();
        LAS float* sc = (LAS float*)lds;
        for (int item = blockIdx.x; item < 192; item += G) {
            const int l = item / 48, r = item % 48, cgp = r >> 3, ks = r & 7;
            __syncthreads();
            for (int e = tid; e < NB * 128; e += NWAVES * 64) { const int b = e >> 7, k = ks * 128 + (e & 127);
                const float cv = b < 4 ? a.c_prompt[b * DM + k] : a.c_sample[(b - 4) * DM + k]; sc[e] = silu_f(cv); }
            __syncthreads();
            const int col = cgp * 512 + tid;
            float acc[NB];
#pragma unroll
            for (int b = 0; b < NB; ++b) acc[b] = 0.f;
            const float* wp = a.w_mod + ((size_t)l * DM + ks * 128) * 3072 + col;
#pragma unroll 4
            for (int k = 0; k < 128; ++k) { const float w = wp[(size_t)k * 3072];
#pragma unroll
                for (int b = 0; b < NB; ++b) acc[b] = fmaf(sc[b * 128 + k], w, acc[b]); }
            const float bias = (ks == 0) ? a.b_mod[l * 3072 + col] : 0.f;
#pragma unroll
            for (int b = 0; b < NB; ++b) atomicAdd(mod + ((size_t)l * NB + b) * 3072 + col, acc[b] + bias);
        }
    }
    SEAM();

    if (RUN()) {
        for (int row = gw; row < NTOK; row += NGW) {
            const int b = batch_of_row(row);
            const float* xr = row < NPROMPT ? a.x_prompt + (size_t)row * DM : a.x_sample + (size_t)(row - NPROMPT) * DM;
            const float* mp = mod + (size_t)b * 3072;
#pragma unroll
            for (int j = 0; j < 4; ++j) { const int c = 4 * lane + 256 * j;
                const f32x4 xv = *(const f32x4*)(xr + c), sh = *(const f32x4*)(mp + c), scl = *(const f32x4*)(mp + 1024 + c);
                const f32x4 uv = xv * (scl + 1.f) + sh;
                u32x2 w; w.x = cvtpk(uv[0], uv[1]); w.y = cvtpk(uv[2], uv[3]);
                *(u32x2*)(U + (size_t)row * DM + c) = w; }
        }
    }
    SEAM();

#pragma unroll 1
    for (int l = 0; l < DEPTH; ++l) {
        const bool isA = (l & 1) == 0; const int li = l >> 1;
        const int nch = isA ? NCH_A : NCH_B, chrows = isA ? CH_A : CH_B, ncols = isA ? IN_A : IN_B;
        const bf16_t* Win = isA ? WinA + (size_t)li * IN_A * DM : WinB + (size_t)li * IN_B * DM;
        const bf16_t* Wout = isA ? WoutA + (size_t)li * DM * DM : WoutB + (size_t)li * DM * DM;
#pragma unroll 1
        for (int c = 0; c < nch; ++c) {
            if (RUN()) {
                pg8::Gemm g{U + (size_t)c * chrows * DM, Win, chrows, ncols, DM}; pg8::StaticOrder S; S.init(chrows, ncols, G, (int)blockIdx.x);
                pg8::EpiBf16<0> E{PROJ, ncols, nullptr, 0, 0, 1.f};
#ifndef NO_GEMM_IN
                pg8::gemm_phase<pg8::EpiBf16<0>, pg8::StaticOrder, true, true>(lds, g, S, E);
#endif
            }
            SEAM();
            if (RUN()) {
                const int row0 = c * chrows; const int S_ = row0 < NPROMPT ? 8192 : 4096;
#ifndef NO_ATT
                if (isA) attn_a_phase(PROJ, ATT + (size_t)row0 * DM, S_, lds, wave, lane);
                else attn_b_phase(PROJ, ATT + (size_t)row0 * DM, S_, a.sink_b + li * 16, lds, wave, lane);
#endif
            }
            SEAM();
        }
        if (RUN()) {
            pg8::Gemm g{ATT, Wout, NTOK, DM, DM}; pg8::StaticOrder S; S.init(NTOK, DM, G, (int)blockIdx.x);
            pg8::EpiRes E{l == 0 ? a.x_prompt : a.out, l == 0 ? a.x_sample : a.out + (size_t)NPROMPT * DM, a.out, mod + (size_t)l * NB * 3072 + 2048, 1.681792830507429f};
#ifndef NO_GEMM_OUT
            pg8::gemm_phase<pg8::EpiRes, pg8::StaticOrder, true, true>(lds, g, S, E);
#endif
        }
        SEAM();
        if (RUN()) {
            const float* gam = a.ln_g + l * DM; const float* bet = a.ln_b + l * DM;
            for (int row = gw; row < NTOK; row += NGW) {
                float* xr = a.out + (size_t)row * DM;
                f32x4 v[4]; float s = 0.f;
#pragma unroll
                for (int j = 0; j < 4; ++j) { v[j] = *(const f32x4*)(xr + 4 * lane + 256 * j); s += (v[j][0] + v[j][1]) + (v[j][2] + v[j][3]); }
                const float mean = wave_sum(s) * (1.f / DM); float s2 = 0.f;
#pragma unroll
                for (int j = 0; j < 4; ++j) { v[j] = v[j] - mean; s2 += (v[j][0] * v[j][0] + v[j][1] * v[j][1]) + (v[j][2] * v[j][2] + v[j][3] * v[j][3]); }
                const float rstd = 1.f / sqrtf(wave_sum(s2) * (1.f / DM) + LN_EPS);
                const int b = batch_of_row(row);
                const float* mp = mod + ((size_t)(l + 1) * NB + b) * 3072;
#pragma unroll
                for (int j = 0; j < 4; ++j) { const int cc = 4 * lane + 256 * j;
                    const f32x4 xo = v[j] * rstd * *(const f32x4*)(gam + cc) + *(const f32x4*)(bet + cc);
                    *(f32x4*)(xr + cc) = xo;
                    if (l + 1 < DEPTH) { const f32x4 sh = *(const f32x4*)(mp + cc), scl = *(const f32x4*)(mp + 1024 + cc); const f32x4 uv = xo * (scl + 1.f) + sh;
                        u32x2 w; w.x = cvtpk(uv[0], uv[1]); w.y = cvtpk(uv[2], uv[3]); *(u32x2*)(U + (size_t)row * DM + cc) = w; } }
            }
        }
        SEAM();
    }
#undef RUN
#undef SEAM
}

constexpr int N_PHASES = 2 + 2 * (2 * NCH_A + 2) + 2 * (2 * NCH_B + 2);
#ifndef ONE_LAUNCH
#define ONE_LAUNCH 1
#endif

extern "C" void kernel_launch(void* const* d_in, const int* in_sizes, int n_in, void* d_out, int out_size, void* d_ws, size_t ws_size, hipStream_t stream) {
    static int grid = 0;
    if (grid == 0) {
        if (n_in != 13 || out_size != NTOK * DM || ws_size < WS_END) { fprintf(stderr, "kernel_launch: unexpected shapes (n_in %d, out %d, ws %zu)\n", n_in, out_size, ws_size); grid = -1; return; }
        int dev = 0, cus = 0, per_cu = 0;
        (void)hipGetDevice(&dev); (void)hipDeviceGetAttribute(&cus, hipDeviceAttributeMultiprocessorCount, dev);
        if (hipFuncSetAttribute((const void*)mk_fwd, hipFuncAttributeMaxDynamicSharedMemorySize, LDS_BYTES) != hipSuccess) { fprintf(stderr, "kernel_launch: hipFuncSetAttribute failed\n"); grid = -1; return; }
        if (hipOccupancyMaxActiveBlocksPerMultiprocessor(&per_cu, (const void*)mk_fwd, NWAVES * 64, LDS_BYTES) != hipSuccess || per_cu < 1) per_cu = 1;
        (void)hipGetLastError();
        if (cus <= 0) cus = 256;
        grid = cus * per_cu;
    }
    if (grid < 0) return;
    (void)hipMemsetAsync((char*)d_ws + WS_MOD, 0, CTL_ZERO_BYTES, stream);
    Args a{};
    a.x_prompt = (const float*)d_in[0]; a.x_sample = (const float*)d_in[1]; a.c_prompt = (const float*)d_in[2]; a.c_sample = (const float*)d_in[3];
    a.w_mod = (const float*)d_in[4]; a.b_mod = (const float*)d_in[5]; a.ln_g = (const float*)d_in[6]; a.ln_b = (const float*)d_in[7];
    a.w_in_a = (const float*)d_in[8]; a.w_out_a = (const float*)d_in[9]; a.w_in_b = (const float*)d_in[10]; a.w_out_b = (const float*)d_in[11]; a.sink_b = (const float*)d_in[12];
    a.out = (float*)d_out; a.ws = (unsigned char*)d_ws;
#if ONE_LAUNCH
    a.ph_lo = 0; a.ph_hi = N_PHASES;
    void* params[] = {&a};
    hipError_t e = hipLaunchCooperativeKernel((const void*)mk_fwd, dim3(grid), dim3(NWAVES * 64), params, LDS_BYTES, stream);
    if (e != hipSuccess) fprintf(stderr, "kernel_launch: cooperative launch failed: %s (grid %d)\n", hipGetErrorString(e), grid);
#else
    for (int k = 0; k < N_PHASES; ++k) { a.ph_lo = k; a.ph_hi = k + 1; hipLaunchKernelGGL(mk_fwd, dim3(grid), dim3(NWAVES * 64), LDS_BYTES, stream, a); }
#endif
}
```

```cpp
#include <hip/hip_runtime.h>
#include <hip/hip_cooperative_groups.h>
#include <cstdio>
#include <cstdint>
namespace cg = cooperative_groups;
namespace pg8 {
#define PG8_LAS __attribute__((address_space(3)))
typedef unsigned short bf16_t;
typedef short bf16x8 __attribute__((ext_vector_type(8)));
typedef float f32x4 __attribute__((ext_vector_type(4)));
typedef unsigned u32x4 __attribute__((ext_vector_type(4)));
constexpr int BM = 256, BK = 64, HALF = 128, HTB = HALF * BK * 2  , STAGE_BYTES = 8 * HTB, NXCD = 8, WGM = 8;

__host__ __device__ __forceinline__ int lds_byte(int r, int c) { const int st = (r >> 4) * 2 + (c >> 5), rr = r & 15, cc = c & 31, ob = rr * 64 + cc * 2; return st * 1024 + (ob ^ (((ob >> 9) & 1) << 5)); }
__host__ __device__ __forceinline__ void stage_rc(int b, int& R, int& C) { const int st = b / 1024, sb = b % 1024, swz = sb ^ (((sb >> 9) & 1) << 5); R = (st >> 1) * 16 + swz / 64; C = (st & 1) * 32 + (swz % 64) / 2; }
__host__ __device__ __forceinline__ int perm32(int rho) { const int n = rho >> 4, i = rho & 15; return 8 * (i >> 2) + 4 * n + (i & 3); }

struct Unit { int pm, pn; };
struct Gemm { const bf16_t* A; const bf16_t* Bt; int M, N, K; };

struct StaticOrder {
    int nM, nN, nwg, G, c;
    __host__ __device__ void init(int M, int N, int G_, int c_) { nM = M / BM; nN = N / BM; nwg = nM * nN; G = G_; c = c_; }
    __host__ __device__ bool next(int i, Unit& u) const {
        const long L = (long)i * G + c; if (L >= nwg) return false;
        int wgid = (int)L; { const int q = nwg / NXCD, r = nwg % NXCD, xcd = wgid % NXCD, off = wgid / NXCD; wgid = (xcd < r ? xcd * (q + 1) : r * (q + 1) + (xcd - r) * q) + off; }
        const int nig = WGM * nN, gid = wgid / nig, fm = gid * WGM, gsz = (nM - fm) < WGM ? (nM - fm) : WGM;
        u.pm = fm + ((wgid % nig) % gsz); u.pn = (wgid % nig) / gsz; return true;
    }
    __device__ __forceinline__ void a_ready(const Unit&) const {}
    __device__ __forceinline__ void done(const Unit&) const {}
};

__device__ __forceinline__ unsigned cvt_pk_bf16(float lo, float hi) { unsigned r; asm volatile("v_cvt_pk_bf16_f32 %0, %1, %2" : "=v"(r) : "v"(lo), "v"(hi)); return r; }
typedef float f32x2 __attribute__((ext_vector_type(2)));
__device__ __forceinline__ f32x2 gelu_pk(f32x2 v) {
    const f32x2 av = __builtin_elementwise_abs(v), d = av * 0.2316418882f + 1.0f;
    f32x2 t; t.x = __builtin_amdgcn_rcpf(d.x); t.y = __builtin_amdgcn_rcpf(d.y);
    f32x2 q = t * 0.5307027145f + (-0.7265760135f); q = q * t + 0.7107068705f; q = q * t + (-0.142248368f); q = q * t + 0.127414796f; q = q * t;
    const f32x2 s = (v * v) * (-0.72134752044f);
    f32x2 e; e.x = __builtin_amdgcn_exp2f(s.x); e.y = __builtin_amdgcn_exp2f(s.y);
    const f32x2 m = v * (q * e), r = v - m;
    f32x2 o; o.x = v.x < 0.f ? m.x : r.x; o.y = v.y < 0.f ? m.y : r.y; return o;
}

template <int ACT  > struct EpiBf16 {
    static constexpr bool PERM = true, AFTER_DRAIN = false; static_assert(ACT == 0 || ACT == 1, "EpiBf16: ACT is 0 (none) or 1 (gelu_pk)");
    bf16_t* O; int ldc; const float* bias; int split_cols; size_t split_stride; float scale0;
    __device__ __forceinline__ void operator()(const f32x4 (&acc)[2][2][4][2], const Unit& u, int wr, int wc, int fr, int fq) const {
        const int row0 = u.pm * BM + wr * 64 + fr; int colt = u.pn * BM; bf16_t* base = O;
        float sc = 1.f; if (split_cols) { const int t = colt / split_cols; base += (size_t)t * split_stride; colt -= t * split_cols; if (t == 0) sc = scale0; }
        const int col0 = colt + wc * 32 + 8 * fq, bcol0 = u.pn * BM + wc * 32 + 8 * fq;
        f32x4 bv[2][2];
#pragma unroll
        for (int bj = 0; bj < 2; ++bj)
#pragma unroll
            for (int n = 0; n < 2; ++n) bv[bj][n] = bias ? *(const f32x4*)(bias + bcol0 + bj * HALF + 4 * n) : (f32x4){0.f, 0.f, 0.f, 0.f};
#pragma unroll
        for (int ai = 0; ai < 2; ++ai)
#pragma unroll
            for (int m = 0; m < 4; ++m) { bf16_t* rowp = base + (size_t)(row0 + ai * HALF + m * 16) * ldc + col0;
#pragma unroll
                for (int bj = 0; bj < 2; ++bj) { f32x4 v0 = acc[ai][bj][m][0] + bv[bj][0], v1 = acc[ai][bj][m][1] + bv[bj][1];
                    if (ACT == 1) { f32x2 a = gelu_pk((f32x2){v0[0], v0[1]}), b = gelu_pk((f32x2){v0[2], v0[3]}), c = gelu_pk((f32x2){v1[0], v1[1]}), d = gelu_pk((f32x2){v1[2], v1[3]});
                        v0 = (f32x4){a.x, a.y, b.x, b.y}; v1 = (f32x4){c.x, c.y, d.x, d.y}; }
                    v0 = v0 * sc; v1 = v1 * sc; u32x4 w; w.x = cvt_pk_bf16(v0[0], v0[1]); w.y = cvt_pk_bf16(v0[2], v0[3]); w.z = cvt_pk_bf16(v1[0], v1[1]); w.w = cvt_pk_bf16(v1[2], v1[3]);
                    *(u32x4*)(rowp + bj * HALF) = w; } }
    }
};
struct EpiRes {
    static constexpr bool PERM = false, AFTER_DRAIN = false;
    const float* xa; const float* xb; float* out; const float* gate_base; float alpha;
    __device__ __forceinline__ void operator()(const f32x4 (&acc)[2][2][4][2], const Unit& u, int wr, int wc, int fr, int fq) const {
        const int rowt = u.pm * BM;
        const int b = rowt < 32768 ? (rowt >> 13) : 4 + ((rowt - 32768) >> 12);
        const float* xs = rowt < 32768 ? xa + (size_t)rowt * 1024 : xb + (size_t)(rowt - 32768) * 1024;
        float* os = out + (size_t)rowt * 1024;
        const float* gp = gate_base + b * 3072;
        const int col0 = u.pn * BM + wc * 32 + 4 * fq;
        f32x4 gv[2][2];
#pragma unroll
        for (int bj = 0; bj < 2; ++bj)
#pragma unroll
            for (int n = 0; n < 2; ++n) gv[bj][n] = *(const f32x4*)(gp + col0 + bj * HALF + n * 16);
#pragma unroll
        for (int ai = 0; ai < 2; ++ai)
#pragma unroll
            for (int m = 0; m < 4; ++m) { const size_t off = (size_t)(wr * 64 + fr + ai * HALF + m * 16) * 1024 + col0;
#pragma unroll
                for (int bj = 0; bj < 2; ++bj)
#pragma unroll
                    for (int n = 0; n < 2; ++n) { const f32x4 xv = *(const f32x4*)(xs + off + bj * HALF + n * 16);
                        *(f32x4*)(os + off + bj * HALF + n * 16) = xv * alpha + gv[bj][n] * acc[ai][bj][m][n]; } }
    }
};
template <class Epi, class Sched, bool ALIGN_EPI = false, bool SP2 = false>
__device__ __forceinline__ void gemm_phase(PG8_LAS unsigned char* lds, const Gemm g, const Sched& S, const Epi& E) {
    int tid_l = threadIdx.x; asm volatile("" : "+v"(tid_l));
    const int tid = tid_l, wid = __builtin_amdgcn_readfirstlane(tid >> 6), lane = tid & 63, wr = wid >> 2, wc = wid & 3, fr = lane & 15, fq = lane >> 4;
    const int K = g.K, nt = K / BK;
    unsigned voffA[2], voffB[2];
#pragma unroll
    for (int i = 0; i < 2; ++i) { int R, C; stage_rc(tid * 16 + i * 8192, R, C); const int Rb = Epi::PERM ? ((R & ~31) + perm32(R & 31)) : R;
        voffA[i] = (unsigned)(R * K + C) * 2u; voffB[i] = (unsigned)(Rb * K + C) * 2u; }
    const size_t kstep = (size_t)(BK * 2);
    const size_t hstep = (size_t)HALF * K * 2;
    const size_t tstep = 2 * hstep;
    const unsigned ldsw = (unsigned)wid * 1024u;
    const int aoff = lds_byte(wr * 64 + fr, fq * 8), boff = lds_byte(wc * 32 + fr, fq * 8);
#define PG8_SA(b, h) (((b) * 2 + (h)) * HTB)
#define PG8_SB(b, h) ((4 + (b) * 2 + (h)) * HTB)
#define PG8_STAGE(bufoff, gbase, voff) do { _Pragma("unroll") for (int _i = 0; _i < 2; ++_i) \
        __builtin_amdgcn_global_load_lds((const unsigned*)((const char*)(gbase) + (voff)[_i]), (PG8_LAS unsigned*)(lds + (bufoff) + ldsw + _i * 8192), 16, 0, 0); } while (0)
#define PG8_LDA(dst, b, h) do { _Pragma("unroll") for (int m = 0; m < 4; ++m) _Pragma("unroll") for (int k = 0; k < 2; ++k) dst[m][k] = *(const PG8_LAS bf16x8*)(lds + PG8_SA(b, h) + aoff + m * 2048 + k * 1024); } while (0)
#define PG8_LDB(dst, b, h) do { _Pragma("unroll") for (int n = 0; n < 2; ++n) _Pragma("unroll") for (int k = 0; k < 2; ++k) dst[n][k] = *(const PG8_LAS bf16x8*)(lds + PG8_SB(b, h) + boff + n * 2048 + k * 1024); } while (0)
#define PG8_MMA(ai, bj, At, Bt) do { __builtin_amdgcn_s_setprio(1); _Pragma("unroll") for (int m = 0; m < 4; ++m) _Pragma("unroll") for (int n = 0; n < 2; ++n) _Pragma("unroll") for (int k = 0; k < 2; ++k) \
        acc[ai][bj][m][n] = __builtin_amdgcn_mfma_f32_16x16x32_bf16(Bt[n][k], At[m][k], acc[ai][bj][m][n], 0, 0, 0); __builtin_amdgcn_s_setprio(0); } while (0)
#define PG8_WAIT_V(n) asm volatile("s_waitcnt vmcnt(" #n ")" ::: "memory")
#define PG8_WAIT_L(n) asm volatile("s_waitcnt lgkmcnt(" #n ")" ::: "memory")
#define PG8_BAR __builtin_amdgcn_s_barrier()
#define PG8_SCHED __builtin_amdgcn_sched_barrier(0)
    Unit cur, nxt; int ui = 0;
    if (!S.next(0, cur)) return;
    f32x4 acc[2][2][4][2];
#pragma unroll
    for (int a = 0; a < 2; ++a)
#pragma unroll
        for (int b = 0; b < 2; ++b)
#pragma unroll
            for (int m = 0; m < 4; ++m)
#pragma unroll
                for (int n = 0; n < 2; ++n) acc[a][b][m][n] = (f32x4){0.f, 0.f, 0.f, 0.f};
    bf16x8 At[4][2], B0[2][2], B1[2][2];
    const char* cA = (const char*)g.A + (size_t)cur.pm * tstep; const char* cB = (const char*)g.Bt + (size_t)cur.pn * tstep;
    S.a_ready(cur);
    if constexpr (SP2) {
        PG8_STAGE(PG8_SB(0, 0), cB, voffB); PG8_STAGE(PG8_SB(0, 1), cB + hstep, voffB); PG8_STAGE(PG8_SA(0, 0), cA, voffA); PG8_STAGE(PG8_SA(0, 1), cA + hstep, voffA);
        if (wr == 1) PG8_BAR;
        PG8_WAIT_V(2); PG8_BAR;
        PG8_STAGE(PG8_SB(1, 0), cB + kstep, voffB); PG8_STAGE(PG8_SA(1, 0), cA + kstep, voffA); PG8_STAGE(PG8_SB(1, 1), cB + hstep + kstep, voffB);
        PG8_WAIT_V(6); PG8_BAR;
    } else {
        PG8_STAGE(PG8_SB(0, 0), cB, voffB); PG8_STAGE(PG8_SA(0, 0), cA, voffA); PG8_STAGE(PG8_SB(0, 1), cB + hstep, voffB); PG8_STAGE(PG8_SA(0, 1), cA + hstep, voffA);
        if (wr == 1) PG8_BAR;
        PG8_WAIT_V(4); PG8_BAR;
        PG8_STAGE(PG8_SB(1, 0), cB + kstep, voffB); PG8_STAGE(PG8_SA(1, 0), cA + kstep, voffA); PG8_STAGE(PG8_SB(1, 1), cB + hstep + kstep, voffB);
        PG8_WAIT_V(6); PG8_BAR;
    }
    for (;;) {
        const bool has_next = S.next(ui + 1, nxt);
        const char* nA = has_next ? (const char*)g.A + (size_t)nxt.pm * tstep : cA; const char* nB = has_next ? (const char*)g.Bt + (size_t)nxt.pn * tstep : cB;
        for (int t = 0; t < nt; t += 2) {
            const bool last = (t == nt - 2);
            const char* a1 = cA + (size_t)(t + 1) * kstep;
            const char* a2 = last ? nA : cA + (size_t)(t + 2) * kstep; const char* b2 = last ? nB : cB + (size_t)(t + 2) * kstep;
            const char* a3 = a2 + kstep; const char* b3 = b2 + kstep;
            if (last && has_next) S.a_ready(nxt);
            if constexpr (SP2) {
            PG8_LDB(B0, 0, 0); PG8_LDB(B1, 0, 1); PG8_SCHED; PG8_LDA(At, 0, 0); PG8_STAGE(PG8_SA(1, 1), a1 + hstep, voffA);
            PG8_WAIT_V(8); PG8_WAIT_L(0); PG8_BAR; PG8_MMA(0, 0, At, B0); PG8_MMA(0, 1, At, B1); PG8_BAR; PG8_SCHED;
            PG8_LDA(At, 0, 1); PG8_STAGE(PG8_SB(0, 0), b2, voffB); PG8_STAGE(PG8_SB(0, 1), b2 + hstep, voffB); PG8_STAGE(PG8_SA(0, 0), a2, voffA);
            PG8_WAIT_V(8); PG8_WAIT_L(0); PG8_BAR; PG8_MMA(1, 0, At, B0); PG8_MMA(1, 1, At, B1); PG8_BAR; PG8_SCHED;
            PG8_LDB(B0, 1, 0); PG8_LDB(B1, 1, 1); PG8_SCHED; PG8_LDA(At, 1, 0); PG8_STAGE(PG8_SA(0, 1), a2 + hstep, voffA);
            PG8_WAIT_V(8); PG8_WAIT_L(0); PG8_BAR; PG8_MMA(0, 0, At, B0); PG8_MMA(0, 1, At, B1); PG8_BAR; PG8_SCHED;
            PG8_LDA(At, 1, 1); PG8_STAGE(PG8_SB(1, 0), b3, voffB); PG8_STAGE(PG8_SB(1, 1), b3 + hstep, voffB); PG8_STAGE(PG8_SA(1, 0), a3, voffA);
            PG8_WAIT_V(8); PG8_WAIT_L(0); PG8_BAR; PG8_MMA(1, 0, At, B0); PG8_MMA(1, 1, At, B1); PG8_BAR; PG8_SCHED;
            } else {
            PG8_LDB(B0, 0, 0); PG8_SCHED; PG8_LDA(At, 0, 0); PG8_STAGE(PG8_SA(1, 1), a1 + hstep, voffA);
            PG8_WAIT_L(8); PG8_BAR; PG8_WAIT_L(0); PG8_MMA(0, 0, At, B0); PG8_BAR; PG8_SCHED;
            PG8_LDB(B1, 0, 1); PG8_STAGE(PG8_SB(0, 0), b2, voffB);
            PG8_BAR; PG8_WAIT_L(0); PG8_MMA(0, 1, At, B1); PG8_BAR;
            PG8_LDA(At, 0, 1); PG8_STAGE(PG8_SA(0, 0), a2, voffA);
            PG8_BAR; PG8_WAIT_L(0); PG8_MMA(1, 0, At, B0); PG8_BAR; PG8_SCHED;
            PG8_STAGE(PG8_SB(0, 1), b2 + hstep, voffB);
            PG8_WAIT_V(6); PG8_BAR; PG8_MMA(1, 1, At, B1); PG8_BAR;
            PG8_LDB(B0, 1, 0); PG8_SCHED; PG8_LDA(At, 1, 0); PG8_STAGE(PG8_SA(0, 1), a2 + hstep, voffA);
            PG8_WAIT_L(8); PG8_BAR; PG8_WAIT_L(0); PG8_MMA(0, 0, At, B0); PG8_BAR; PG8_SCHED;
            PG8_LDB(B1, 1, 1); PG8_STAGE(PG8_SB(1, 0), b3, voffB);
            PG8_BAR; PG8_WAIT_L(0); PG8_MMA(0, 1, At, B1); PG8_BAR;
            PG8_LDA(At, 1, 1); PG8_STAGE(PG8_SA(1, 0), a3, voffA);
            PG8_BAR; PG8_WAIT_L(0); PG8_MMA(1, 0, At, B0); PG8_BAR; PG8_SCHED;
            PG8_STAGE(PG8_SB(1, 1), b3 + hstep, voffB);
            PG8_WAIT_V(6); PG8_BAR; PG8_MMA(1, 1, At, B1); PG8_BAR;
            }
        }
        if constexpr (ALIGN_EPI) { if (wr == 0) PG8_BAR; }
        if constexpr (!Epi::AFTER_DRAIN) { E(acc, cur, wr, wc, fr, fq); S.done(cur); }
        if (!has_next) break;
#pragma unroll
        for (int a = 0; a < 2; ++a)
#pragma unroll
            for (int b = 0; b < 2; ++b)
#pragma unroll
                for (int m = 0; m < 4; ++m)
#pragma unroll
                    for (int n = 0; n < 2; ++n) acc[a][b][m][n] = (f32x4){0.f, 0.f, 0.f, 0.f};
        cur = nxt; cA = nA; cB = nB; ++ui;
        if constexpr (ALIGN_EPI) { if (wr == 1) PG8_BAR; }
    }
    PG8_WAIT_V(0);
    if constexpr (!ALIGN_EPI) { if (wr == 0) PG8_BAR; }
    PG8_BAR;
    if constexpr (Epi::AFTER_DRAIN) { E.fused(acc, cur, wr, wc, fr, fq, lds, wid, lane); S.done(cur); }
#undef PG8_SA
#undef PG8_SB
#undef PG8_STAGE
#undef PG8_LDA
#undef PG8_LDB
#undef PG8_MMA
#undef PG8_WAIT_V
#undef PG8_WAIT_L
#undef PG8_BAR
#undef PG8_SCHED
}
}
constexpr int DM = 1024, NTOK = 65536, NPROMPT = 32768, NB = 12, DEPTH = 4;
constexpr int IN_A = 10240, IN_B = 2560;
constexpr int CH_A = 8192, NCH_A = 8, CH_B = 32768, NCH_B = 2;
constexpr float LN_EPS = 1e-5f;
constexpr float LOG2E = 1.4426950408889634f;
constexpr float CSCALE = 0.125f * LOG2E;
constexpr size_t MiB = 1u << 20;
constexpr size_t WS_MOD = 0, CTL_ZERO_BYTES = 1 * MiB;
constexpr size_t WS_BAR = 640 * 1024;
constexpr size_t WS_WINA = 2 * MiB;
constexpr size_t WS_WOUTA = 42 * MiB;
constexpr size_t WS_WINB = 46 * MiB;
constexpr size_t WS_WOUTB = 56 * MiB;
constexpr size_t WS_U = 64 * MiB;
constexpr size_t WS_ATT = 192 * MiB;
constexpr size_t WS_PROJ = 320 * MiB;
constexpr size_t WS_END = 480 * MiB;
constexpr int LDS_BYTES = 147456;
constexpr int NWAVES = 8;

#define LAS __attribute__((address_space(3)))
typedef unsigned short bf16_t;
typedef short bf16x8 __attribute__((ext_vector_type(8)));
typedef short s16x4 __attribute__((ext_vector_type(4)));
typedef float f32x4 __attribute__((ext_vector_type(4)));
typedef float f32x2 __attribute__((ext_vector_type(2)));
typedef unsigned u32x4 __attribute__((ext_vector_type(4)));
typedef unsigned u32x2 __attribute__((ext_vector_type(2)));
typedef __bf16 bf16x2_t __attribute__((ext_vector_type(2)));
typedef short v4i16_t __attribute__((ext_vector_type(4)));

__device__ __forceinline__ unsigned cvtpk(float lo, float hi) { f32x2 v = {lo, hi}; bf16x2_t b = __builtin_convertvector(v, bf16x2_t); return __builtin_bit_cast(unsigned, b); }
__device__ __forceinline__ float bf_lo(unsigned w) { return __uint_as_float(w << 16); }
__device__ __forceinline__ float bf_hi(unsigned w) { return __uint_as_float(w & 0xffff0000u); }
__device__ __forceinline__ float silu_f(float z) { return z / (1.f + __expf(-z)); }
__device__ __forceinline__ int batch_of_row(int row) { return row < NPROMPT ? (row >> 13) : 4 + ((row - NPROMPT) >> 12); }
__device__ __forceinline__ float wave_sum(float v) {
#pragma unroll
    for (int o = 1; o < 64; o <<= 1) v += __shfl_xor(v, o);
    return v;
}

#define XB_TMO      128
#define XB_XCNT(j)  (256  + 64 * (j))
#define XB_XSUB(j)  (1280 + 64 * (j))
#define XB_XGEN(j)  (2304 + 64 * (j))
#define XB_TOP      3328
#define XB_TOPGEN   3392
#define XCD_BAR_WORDS 3456
#define XB_SPIN_CAP (1u << 18)

__device__ __forceinline__ unsigned xb_ld(unsigned* p)              { return __hip_atomic_load(p, __ATOMIC_RELAXED, __HIP_MEMORY_SCOPE_AGENT); }
__device__ __forceinline__ unsigned xb_add(unsigned* p, unsigned v) { return __hip_atomic_fetch_add(p, v, __ATOMIC_RELAXED, __HIP_MEMORY_SCOPE_AGENT); }
__device__ __forceinline__ unsigned xb_xcc_id() { return (unsigned)__builtin_amdgcn_s_getreg((3 << 11) | 20) & 0xFu; }
#define XB_SPIN(cond, bar) do { unsigned _sp = 0; while (cond) { __builtin_amdgcn_s_sleep(1); \
    if ((++_sp & 255u) == 0u) { if (xb_ld(&(bar)[XB_TMO])) break; if (_sp > XB_SPIN_CAP) { atomicAdd(&(bar)[XB_TMO], 1u); break; } } } } while (0)

struct XcdBarrier {
    unsigned* bar; unsigned x;
    volatile LAS unsigned* st;
};

__device__ __forceinline__ XcdBarrier xcd_barrier_post(unsigned* bar, volatile LAS unsigned* st) {
    XcdBarrier b; b.bar = bar; b.x = xb_xcc_id(); b.st = st;
    if (threadIdx.x == 0) (void)xb_add(&bar[XB_XCNT(b.x)], 1u);
    return b;
}
__device__ __forceinline__ void xcd_barrier_complete(unsigned* bar, unsigned x, unsigned& nloc, unsigned& nx) {
    const unsigned G = gridDim.x * gridDim.y * gridDim.z;
    unsigned sum, cnt, mine, sp = 0u;
    for (;;) {
        sum = 0u; cnt = 0u; mine = 0u;
#pragma unroll
        for (unsigned j = 0; j < 16; ++j) { const unsigned c = xb_ld(&bar[XB_XCNT(j)]); sum += c; cnt += (c > 0u) ? 1u : 0u; mine = (j == x) ? c : mine; }
        if (sum == G) break;
        __builtin_amdgcn_s_sleep(1);
        if ((++sp & 255u) == 0u) { if (xb_ld(&bar[XB_TMO])) break; if (sp > XB_SPIN_CAP) { atomicAdd(&bar[XB_TMO], 1u); break; } }
    }
    nloc = mine > 0u ? mine : 1u; nx = cnt > 0u ? cnt : 1u;
}

__device__ __forceinline__ void xcd_barrier(const XcdBarrier& b) {
    asm volatile("s_waitcnt vmcnt(0)" ::: "memory");
    __syncthreads();
    if (threadIdx.x == 0) {
        unsigned* bar = b.bar;
        __builtin_amdgcn_s_waitcnt(0);
        unsigned nloc = b.st[0], nx = b.st[1];
        if (nloc == 0u) { xcd_barrier_complete(bar, b.x, nloc, nx); b.st[0] = nloc; b.st[1] = nx; }
        const unsigned old = xb_add(&bar[XB_XSUB(b.x)], 1u);
        const unsigned gen = old / nloc;
        if (old + 1u == (gen + 1u) * nloc) {
            __builtin_amdgcn_fence(__ATOMIC_RELEASE, "agent");
            asm volatile("s_waitcnt vmcnt(0)" ::: "memory");
            const unsigned og = xb_add(&bar[XB_TOP], 1u);
            const unsigned tg = og / nx;
            if (og + 1u == (tg + 1u) * nx) xb_add(&bar[XB_TOPGEN], 1u);
            else XB_SPIN(xb_ld(&bar[XB_TOPGEN]) == tg, bar);
            __builtin_amdgcn_fence(__ATOMIC_ACQUIRE, "agent");
            xb_add(&bar[XB_XGEN(b.x)], 1u);
            asm volatile("s_waitcnt vmcnt(0)" ::: "memory");
        } else {
            XB_SPIN(xb_ld(&bar[XB_XGEN(b.x)]) == gen, bar);
            __builtin_amdgcn_fence(__ATOMIC_ACQUIRE, "agent");
            asm volatile("s_waitcnt vmcnt(0)" ::: "memory");
        }
    }
    __syncthreads();
}

__device__ __forceinline__ void sm_step(const f32x4 (&sa)[2], float rb, float lo, float hi, float slope2, LAS unsigned char* vb, float& m, float& l, f32x4 (&o)[4]) {
    float sc[8];
#pragma unroll
    for (int t_ = 0; t_ < 2; ++t_)
#pragma unroll
        for (int r = 0; r < 4; ++r) {
            const float relf = rb + (float)(16 * t_ + r);
            const float v = fmaf(-slope2, fabsf(relf), sa[t_][r] * CSCALE);
            sc[4 * t_ + r] = (relf >= lo && relf <= hi) ? v : -1e30f;
        }
    float mx = fmaxf(fmaxf(fmaxf(sc[0], sc[1]), fmaxf(sc[2], sc[3])), fmaxf(fmaxf(sc[4], sc[5]), fmaxf(sc[6], sc[7])));
    mx = fmaxf(mx, __shfl_xor(mx, 16)); mx = fmaxf(mx, __shfl_xor(mx, 32));
    const float mn = fmaxf(m, mx), alpha = __builtin_amdgcn_exp2f(m - mn); m = mn;
    float ps = 0.f;
#pragma unroll
    for (int k = 0; k < 8; ++k) { sc[k] = __builtin_amdgcn_exp2f(sc[k] - mn); ps += sc[k]; }
    l = l * alpha + ps;
#pragma unroll
    for (int n = 0; n < 4; ++n) o[n] = o[n] * alpha;
    u32x4 pw; pw.x = cvtpk(sc[0], sc[1]); pw.y = cvtpk(sc[2], sc[3]); pw.z = cvtpk(sc[4], sc[5]); pw.w = cvtpk(sc[6], sc[7]);
    const bf16x8 pb = __builtin_bit_cast(bf16x8, pw);
#pragma unroll
    for (int n = 0; n < 4; ++n) {
        const s16x4 v0 = __builtin_bit_cast(s16x4, __builtin_amdgcn_ds_read_tr16_b64_v4i16((LAS v4i16_t*)(vb + n * 32)));
        const s16x4 v1 = __builtin_bit_cast(s16x4, __builtin_amdgcn_ds_read_tr16_b64_v4i16((LAS v4i16_t*)(vb + n * 32 + 2560)));
        const bf16x8 va = (bf16x8){v0[0], v0[1], v0[2], v0[3], v1[0], v1[1], v1[2], v1[3]};
        o[n] = __builtin_amdgcn_mfma_f32_16x16x32_bf16(va, pb, o[n], 0, 0, 0);
    }
}
template <int D_, int NS, int QSTEP, int NSTEPS>
__device__ __forceinline__ void group_pass(const bf16_t* __restrict__ Pq, const bf16_t* __restrict__ Pk, const bf16_t* __restrict__ Pv, int pitch, int S, int t0, int tq,
                                           float slope2, LAS unsigned char* vl, int lane, float& m, float& l, f32x4 (&o)[4]) {
    const int i = lane & 15, g = lane >> 4;
    bf16x8 qb[2];
#pragma unroll
    for (int s = 0; s < 2; ++s) qb[s] = *(const bf16x8*)(Pq + (size_t)tq * pitch + 8 * g + 32 * s);
    const float relbase = (float)(-NS + 4 * g - QSTEP * i);
    const int lo_i = -(tq / D_), hi_i = (S - 1 - tq) / D_;
    const float lo = (float)(lo_i > -NS ? lo_i : -NS), hi = (float)(hi_i < NS ? hi_i : NS);
    const int vk = lane >> 3, vc = lane & 7;
    const bf16_t* kp = Pk + 8 * g;
    const bf16_t* vp = Pv + 8 * vc;
    LAS unsigned char* vw = vl + vk * 160 + vc * 16;
    LAS unsigned char* vb = vl + (4 * g + ((lane & 15) >> 2)) * 160 + 8 * (lane & 3);
    bf16x8 kn[2][2]; u32x4 vn[4];
#define ATT_LOAD(st_) do { \
        _Pragma("unroll") for (int t_ = 0; t_ < 2; ++t_) { int tk = t0 + D_ * (32 * (st_) + 16 * t_ + i - NS); tk = tk < 0 ? 0 : (tk > S - 1 ? S - 1 : tk); \
            _Pragma("unroll") for (int s = 0; s < 2; ++s) kn[t_][s] = *(const bf16x8*)(kp + (size_t)tk * pitch + 32 * s); } \
        _Pragma("unroll") for (int c = 0; c < 4; ++c) { int tk = t0 + D_ * (32 * (st_) + 8 * c + vk - NS); tk = tk < 0 ? 0 : (tk > S - 1 ? S - 1 : tk); \
            vn[c] = *(const u32x4*)(vp + (size_t)tk * pitch); } } while (0)
    ATT_LOAD(0);
#pragma unroll 1
    for (int st = 0; st < NSTEPS; ++st) {
        bf16x8 kc[2][2]; u32x4 vcur[4];
#pragma unroll
        for (int t_ = 0; t_ < 2; ++t_)
#pragma unroll
            for (int s = 0; s < 2; ++s) kc[t_][s] = kn[t_][s];
#pragma unroll
        for (int c = 0; c < 4; ++c) vcur[c] = vn[c];
        if (st + 1 < NSTEPS) ATT_LOAD(st + 1);
#pragma unroll
        for (int c = 0; c < 4; ++c) *(LAS u32x4*)(vw + c * 1280) = vcur[c];
        f32x4 sa[2];
#pragma unroll
        for (int t_ = 0; t_ < 2; ++t_) {
            sa[t_] = __builtin_amdgcn_mfma_f32_16x16x32_bf16(kc[t_][0], qb[0], (f32x4){0.f, 0.f, 0.f, 0.f}, 0, 0, 0);
            sa[t_] = __builtin_amdgcn_mfma_f32_16x16x32_bf16(kc[t_][1], qb[1], sa[t_], 0, 0, 0);
        }
        sm_step(sa, relbase + (float)(32 * st), lo, hi, slope2, vb, m, l, o);
    }
#undef ATT_LOAD
}
constexpr int KROW = 144, VROW = 160, WROWS = 416;
constexpr int WIN_K = 0, WIN_V = WROWS * KROW, WIN_BYTES = WROWS * (KROW + VROW);
template <int NS, int QSTEP, int NSTEPS>
__device__ __forceinline__ void group_pass_lds(const bf16_t* __restrict__ Pq, int pitch, int S, int tq, float slope2, LAS unsigned char* Kl, LAS unsigned char* Vl,
                                               int lane, float& m, float& l, f32x4 (&o)[4]) {
    const int i = lane & 15, g = lane >> 4;
    bf16x8 qb[2];
#pragma unroll
    for (int s = 0; s < 2; ++s) qb[s] = *(const bf16x8*)(Pq + (size_t)tq * pitch + 8 * g + 32 * s);
    const float relbase = (float)(-NS + 4 * g - QSTEP * i);
    const int lo_i = -tq, hi_i = S - 1 - tq;
    const float lo = (float)(lo_i > -NS ? lo_i : -NS), hi = (float)(hi_i < NS ? hi_i : NS);
    LAS unsigned char* kb = Kl + i * KROW + 16 * g;
    LAS unsigned char* vb = Vl + (4 * g + ((lane & 15) >> 2)) * VROW + 8 * (lane & 3);
#pragma unroll 1
    for (int st = 0; st < NSTEPS; ++st) {
        f32x4 sa[2];
#pragma unroll
        for (int t_ = 0; t_ < 2; ++t_) {
            const bf16x8 k0 = *(LAS bf16x8*)(kb + (32 * st + 16 * t_) * KROW), k1 = *(LAS bf16x8*)(kb + (32 * st + 16 * t_) * KROW + 64);
            sa[t_] = __builtin_amdgcn_mfma_f32_16x16x32_bf16(k0, qb[0], (f32x4){0.f, 0.f, 0.f, 0.f}, 0, 0, 0);
            sa[t_] = __builtin_amdgcn_mfma_f32_16x16x32_bf16(k1, qb[1], sa[t_], 0, 0, 0);
        }
        sm_step(sa, relbase + (float)(32 * st), lo, hi, slope2, vb + 32 * st * VROW, m, l, o);
    }
}
__device__ __forceinline__ void stage_window(const bf16_t* __restrict__ Pk, const bf16_t* __restrict__ Pv, int pitch, int S, int w0, LAS unsigned char* lds, int tid) {
    u32x4 kr[7], vr[7];
#pragma unroll
    for (int j = 0; j < 7; ++j) { const int e = tid + 512 * j, row = e >> 3, ch = e & 7; int tk = w0 + row; tk = tk < 0 ? 0 : (tk > S - 1 ? S - 1 : tk);
        if (e < WROWS * 8) { kr[j] = *(const u32x4*)(Pk + (size_t)tk * pitch + ch * 8); vr[j] = *(const u32x4*)(Pv + (size_t)tk * pitch + ch * 8); } }
#pragma unroll
    for (int j = 0; j < 7; ++j) { const int e = tid + 512 * j, row = e >> 3, ch = e & 7;
        if (e < WROWS * 8) { *(LAS u32x4*)(lds + WIN_K + row * KROW + ch * 16) = kr[j]; *(LAS u32x4*)(lds + WIN_V + row * VROW + ch * 16) = vr[j]; } }
}

__device__ __forceinline__ void attn_store(const bf16_t* __restrict__ Pz, int pitch, int tq, bf16_t* __restrict__ orow0  , int lane, float l, const f32x4 (&o)[4]) {
    const int g = lane >> 4;
    float lt = l + __shfl_xor(l, 16); lt = lt + __shfl_xor(lt, 32);
    const float inv = 1.f / lt;
#pragma unroll
    for (int n = 0; n < 4; ++n) {
        const u32x2 zw = *(const u32x2*)(Pz + (size_t)tq * pitch + 16 * n + 4 * g);
        const float a0 = o[n][0] * inv * silu_f(bf_lo(zw.x)), a1 = o[n][1] * inv * silu_f(bf_hi(zw.x));
        const float a2 = o[n][2] * inv * silu_f(bf_lo(zw.y)), a3 = o[n][3] * inv * silu_f(bf_hi(zw.y));
        u32x2 w; w.x = cvtpk(a0, a1); w.y = cvtpk(a2, a3);
        *(u32x2*)(orow0 + (size_t)tq * 1024 + 16 * n + 4 * g) = w;
    }
}

__device__ __forceinline__ void attn_a_phase(const bf16_t* P, bf16_t* A, int S, LAS unsigned char* lds, int wave, int lane_in, int tid_in) {
    int lane = lane_in, tid = tid_in; asm volatile("" : "+v"(lane), "+v"(tid));
    LAS unsigned char* vl = lds + wave * 5120;
    for (int bu = blockIdx.x; bu < 512; bu += gridDim.x) {
        const int tile = bu >> 4, h = bu & 15;
        const int tc0 = tile * 256, seq0 = (tc0 / S) * S, T = tc0 - seq0;
        const bf16_t* Ps = P + (size_t)seq0 * IN_A + h * 64;
        const float slope = __builtin_amdgcn_exp2f(-0.5f * (float)(h + 1)) * LOG2E;
        __syncthreads();
        stage_window(Ps + 1024, Ps + 2048, IN_A, S, T - 64, lds, tid);
        __syncthreads();
        float m[2], l[2]; f32x4 o[2][4];
#pragma unroll
        for (int it = 0; it < 2; ++it) {
            const int res = wave + 8 * it, tq = T + res + 16 * (lane & 15);
            m[it] = -1e30f; l[it] = 0.f;
#pragma unroll
            for (int n = 0; n < 4; ++n) o[it][n] = (f32x4){0.f, 0.f, 0.f, 0.f};
            group_pass_lds<64, 16, 12>(Ps, IN_A, S, tq, slope, lds + WIN_K + res * KROW, lds + WIN_V + res * VROW, lane, m[it], l[it], o[it]);
        }
        __syncthreads();
#pragma unroll
        for (int it = 0; it < 2; ++it) {
            const int res = wave + 8 * it, t0 = T + res, tq = t0 + 16 * (lane & 15);
            group_pass<4, 64, 4, 6>(Ps + 3072, Ps + 4096, Ps + 5120, IN_A, S, t0, tq, slope * 4.f, vl, lane, m[it], l[it], o[it]);
            group_pass<16, 64, 1, 5>(Ps + 6144, Ps + 7168, Ps + 8192, IN_A, S, t0, tq, slope * 16.f, vl, lane, m[it], l[it], o[it]);
            attn_store(Ps + 9216, IN_A, tq, A + (size_t)seq0 * 1024 + h * 64, lane, l[it], o[it]);
        }
    }
}
__device__ __forceinline__ void attn_b_phase(const bf16_t* P, bf16_t* A, int S, const float* sink, LAS unsigned char* lds, int wave, int lane_in, int tid_in) {
    int lane = lane_in, tid = tid_in; asm volatile("" : "+v"(lane), "+v"(tid));
    for (int bu = blockIdx.x; bu < 1024; bu += gridDim.x) {
        const int tile = bu >> 2, kvh = bu & 3;
        const int tc0 = tile * 128, seq0 = (tc0 / S) * S, T = tc0 - seq0;
        const bf16_t* Ps = P + (size_t)seq0 * IN_B;
        __syncthreads();
        stage_window(Ps + 1024 + kvh * 64, Ps + 1280 + kvh * 64, IN_B, S, T - 128, lds, tid);
        __syncthreads();
#pragma unroll 1
        for (int it = 0; it < 4; ++it) {
            const int h = kvh * 4 + it, sub = wave, t0 = T + 16 * sub, tq = t0 + (lane & 15);
            const float slope = __builtin_amdgcn_exp2f(-0.5f * (float)(h + 1)) * LOG2E;
            float m = sink[h] * LOG2E, l = (lane < 16) ? 1.f : 0.f; f32x4 o[4];
#pragma unroll
            for (int n = 0; n < 4; ++n) o[n] = (f32x4){0.f, 0.f, 0.f, 0.f};
            group_pass_lds<128, 1, 9>(Ps + h * 64, IN_B, S, tq, slope, lds + WIN_K + 16 * sub * KROW, lds + WIN_V + 16 * sub * VROW, lane, m, l, o);
            attn_store(Ps + 1536 + h * 64, IN_B, tq, A + (size_t)seq0 * 1024 + h * 64, lane, l, o);
        }
    }
}

__device__ __forceinline__ unsigned f2bf(float f) { unsigned u = __builtin_bit_cast(unsigned, f); return (u + 0x7fffu + ((u >> 16) & 1u)) >> 16; }
__device__ __forceinline__ unsigned pk2(float lo, float hi) { return f2bf(lo) | (f2bf(hi) << 16); }
__device__ __forceinline__ void transpose_item(const float* __restrict__ W, int K, int N, bf16_t* __restrict__ WT, LAS float* scr, int item, int lane) {
    const int nblk = N / 32, kb = item / nblk, nb = item % nblk, k0 = 64 * kb, n0 = 32 * nb;
#pragma unroll 8
    for (int i = 0; i < 32; ++i) { const int kk = 2 * i + (lane >> 5); scr[kk * 33 + (lane & 31)] = W[(size_t)(k0 + kk) * N + n0 + (lane & 31)]; }
    asm volatile("s_waitcnt lgkmcnt(0)" ::: "memory");
    const int c = lane & 7;
#pragma unroll
    for (int j = 0; j < 4; ++j) { const int n = (lane >> 3) + 8 * j; const LAS float* s = scr + (8 * c) * 33 + n;
        u32x4 o; o.x = pk2(s[0 * 33], s[1 * 33]); o.y = pk2(s[2 * 33], s[3 * 33]); o.z = pk2(s[4 * 33], s[5 * 33]); o.w = pk2(s[6 * 33], s[7 * 33]);
        *(u32x4*)(WT + (size_t)(n0 + n) * K + k0 + 8 * c) = o; }
    asm volatile("s_waitcnt lgkmcnt(0)" ::: "memory");
}

struct Args {
    const float *x_prompt, *x_sample, *c_prompt, *c_sample, *w_mod, *b_mod, *ln_g, *ln_b, *w_in_a, *w_out_a, *w_in_b, *w_out_b, *sink_b;
    float* out; unsigned char* ws; int ph_lo, ph_hi;
};

__global__ void __launch_bounds__(NWAVES * 64, 2) mk_fwd(Args a) {
    extern __shared__ __attribute__((aligned(16))) unsigned char lds_raw[];
    LAS unsigned char* lds = (LAS unsigned char*)lds_raw;
    cg::grid_group grid = cg::this_grid();
    const int tid = threadIdx.x, lane = tid & 63, wave = __builtin_amdgcn_readfirstlane(tid >> 6);
    const int G = gridDim.x, gw = blockIdx.x * NWAVES + wave, NGW = G * NWAVES;
    unsigned char* ws = a.ws;
    float* mod = (float*)(ws + WS_MOD);
    bf16_t* WinA = (bf16_t*)(ws + WS_WINA); bf16_t* WoutA = (bf16_t*)(ws + WS_WOUTA); bf16_t* WinB = (bf16_t*)(ws + WS_WINB); bf16_t* WoutB = (bf16_t*)(ws + WS_WOUTB);
    bf16_t* U = (bf16_t*)(ws + WS_U); bf16_t* ATT = (bf16_t*)(ws + WS_ATT); bf16_t* PROJ = (bf16_t*)(ws + WS_PROJ);
    volatile LAS unsigned* bst = (volatile LAS unsigned*)(lds + 131072 + 64);
    if (tid < 2) bst[tid] = 0u;
    __syncthreads();
    XcdBarrier bar; bar.bar = (unsigned*)(ws + WS_BAR); bar.x = 0; bar.st = bst;
    if (a.ph_hi - a.ph_lo > 1) bar = xcd_barrier_post((unsigned*)(ws + WS_BAR), bst);
    int pc = 0;
#define RUN() (a.ph_lo <= pc && pc < a.ph_hi)
#define SEAM() do { if (a.ph_lo <= pc && pc + 1 < a.ph_hi) { if (pc == 0) grid.sync(); else xcd_barrier(bar); } ++pc; } while (0)

    if (RUN()) {
        LAS float* scr = (LAS float*)(lds + wave * 16384);
        constexpr int I_INA = 16 * (IN_A / 32), I_OUT = 16 * 32, I_INB = 16 * (IN_B / 32);
        constexpr int NITEMS = 2 * I_INA + 2 * I_OUT + 2 * I_INB + 2 * I_OUT;
        for (int it = gw; it < NITEMS; it += NGW) {
            int r = it;
            if (r < 2 * I_INA) { const int li = r / I_INA; transpose_item(a.w_in_a + (size_t)li * DM * IN_A, DM, IN_A, WinA + (size_t)li * IN_A * DM, scr, r % I_INA, lane); continue; } r -= 2 * I_INA;
            if (r < 2 * I_OUT) { const int li = r / I_OUT; transpose_item(a.w_out_a + (size_t)li * DM * DM, DM, DM, WoutA + (size_t)li * DM * DM, scr, r % I_OUT, lane); continue; } r -= 2 * I_OUT;
            if (r < 2 * I_INB) { const int li = r / I_INB; transpose_item(a.w_in_b + (size_t)li * DM * IN_B, DM, IN_B, WinB + (size_t)li * IN_B * DM, scr, r % I_INB, lane); continue; } r -= 2 * I_INB;
            { const int li = r / I_OUT; transpose_item(a.w_out_b + (size_t)li * DM * DM, DM, DM, WoutB + (size_t)li * DM * DM, scr, r % I_OUT, lane); }
        }
        __syncthreads();
        LAS float* sc = (LAS float*)lds;
        for (int item = blockIdx.x; item < 192; item += G) {
            const int l = item / 48, r = item % 48, cgp = r >> 3, ks = r & 7;
            __syncthreads();
            for (int e = tid; e < NB * 128; e += NWAVES * 64) { const int b = e >> 7, k = ks * 128 + (e & 127);
                const float cv = b < 4 ? a.c_prompt[b * DM + k] : a.c_sample[(b - 4) * DM + k]; sc[e] = silu_f(cv); }
            __syncthreads();
            const int col = cgp * 512 + tid;
            float acc[NB];
#pragma unroll
            for (int b = 0; b < NB; ++b) acc[b] = 0.f;
            const float* wp = a.w_mod + ((size_t)l * DM + ks * 128) * 3072 + col;
#pragma unroll 4
            for (int k = 0; k < 128; ++k) { const float w = wp[(size_t)k * 3072];
#pragma unroll
                for (int b = 0; b < NB; ++b) acc[b] = fmaf(sc[b * 128 + k], w, acc[b]); }
            const float bias = (ks == 0) ? a.b_mod[l * 3072 + col] : 0.f;
#pragma unroll
            for (int b = 0; b < NB; ++b) atomicAdd(mod + ((size_t)l * NB + b) * 3072 + col, acc[b] + bias);
        }
    }
    SEAM();

    if (RUN()) {
        for (int row = gw; row < NTOK; row += NGW) {
            const int b = batch_of_row(row);
            const float* xr = row < NPROMPT ? a.x_prompt + (size_t)row * DM : a.x_sample + (size_t)(row - NPROMPT) * DM;
            const float* mp = mod + (size_t)b * 3072;
#pragma unroll
            for (int j = 0; j < 4; ++j) { const int c = 4 * lane + 256 * j;
                const f32x4 xv = *(const f32x4*)(xr + c), sh = *(const f32x4*)(mp + c), scl = *(const f32x4*)(mp + 1024 + c);
                const f32x4 uv = xv * (scl + 1.f) + sh;
                u32x2 w; w.x = cvtpk(uv[0], uv[1]); w.y = cvtpk(uv[2], uv[3]);
                *(u32x2*)(U + (size_t)row * DM + c) = w; }
        }
    }
    SEAM();

#pragma unroll 1
    for (int l = 0; l < DEPTH; ++l) {
        const bool isA = (l & 1) == 0; const int li = l >> 1;
        const int nch = isA ? NCH_A : NCH_B, chrows = isA ? CH_A : CH_B, ncols = isA ? IN_A : IN_B;
        const bf16_t* Win = isA ? WinA + (size_t)li * IN_A * DM : WinB + (size_t)li * IN_B * DM;
        const bf16_t* Wout = isA ? WoutA + (size_t)li * DM * DM : WoutB + (size_t)li * DM * DM;
#pragma unroll 1
        for (int c = 0; c < nch; ++c) {
            if (RUN()) {
                pg8::Gemm g{U + (size_t)c * chrows * DM, Win, chrows, ncols, DM}; pg8::StaticOrder S; S.init(chrows, ncols, G, (int)blockIdx.x);
                pg8::EpiBf16<0> E{PROJ, ncols, nullptr, 0, 0, 1.f};
#ifndef NO_GEMM_IN
                pg8::gemm_phase<pg8::EpiBf16<0>, pg8::StaticOrder, true, true>(lds, g, S, E);
#endif
            }
            SEAM();
            if (RUN()) {
                const int row0 = c * chrows; const int S_ = row0 < NPROMPT ? 8192 : 4096;
#ifndef NO_ATT
                if (isA) attn_a_phase(PROJ, ATT + (size_t)row0 * DM, S_, lds, wave, lane, tid);
                else attn_b_phase(PROJ, ATT + (size_t)row0 * DM, S_, a.sink_b + li * 16, lds, wave, lane, tid);
#endif
            }
            SEAM();
        }
        if (RUN()) {
            pg8::Gemm g{ATT, Wout, NTOK, DM, DM}; pg8::StaticOrder S; S.init(NTOK, DM, G, (int)blockIdx.x);
            pg8::EpiRes E{l == 0 ? a.x_prompt : a.out, l == 0 ? a.x_sample : a.out + (size_t)NPROMPT * DM, a.out, mod + (size_t)l * NB * 3072 + 2048, 1.681792830507429f};
#ifndef NO_GEMM_OUT
            pg8::gemm_phase<pg8::EpiRes, pg8::StaticOrder, true, true>(lds, g, S, E);
#endif
        }
        SEAM();
        if (RUN()) {
            const float* gam = a.ln_g + l * DM; const float* bet = a.ln_b + l * DM;
            for (int row = gw; row < NTOK; row += NGW) {
                float* xr = a.out + (size_t)row * DM;
                f32x4 v[4]; float s = 0.f;
#pragma unroll
                for (int j = 0; j < 4; ++j) { v[j] = *(const f32x4*)(xr + 4 * lane + 256 * j); s += (v[j][0] + v[j][1]) + (v[j][2] + v[j][3]); }
                const float mean = wave_sum(s) * (1.f / DM); float s2 = 0.f;
#pragma unroll
                for (int j = 0; j < 4; ++j) { v[j] = v[j] - mean; s2 += (v[j][0] * v[j][0] + v[j][1] * v[j][1]) + (v[j][2] * v[j][2] + v[j][3] * v[j][3]); }
                const float rstd = 1.f / sqrtf(wave_sum(s2) * (1.f / DM) + LN_EPS);
                const int b = batch_of_row(row);
                const float* mp = mod + ((size_t)(l + 1) * NB + b) * 3072;
#pragma unroll
                for (int j = 0; j < 4; ++j) { const int cc = 4 * lane + 256 * j;
                    const f32x4 xo = v[j] * rstd * *(const f32x4*)(gam + cc) + *(const f32x4*)(bet + cc);
                    *(f32x4*)(xr + cc) = xo;
                    if (l + 1 < DEPTH) { const f32x4 sh = *(const f32x4*)(mp + cc), scl = *(const f32x4*)(mp + 1024 + cc); const f32x4 uv = xo * (scl + 1.f) + sh;
                        u32x2 w; w.x = cvtpk(uv[0], uv[1]); w.y = cvtpk(uv[2], uv[3]); *(u32x2*)(U + (size_t)row * DM + cc) = w; } }
            }
        }
        SEAM();
    }
#undef RUN
#undef SEAM
}

constexpr int N_PHASES = 2 + 2 * (2 * NCH_A + 2) + 2 * (2 * NCH_B + 2);
#ifndef ONE_LAUNCH
#define ONE_LAUNCH 1
#endif

extern "C" void kernel_launch(void* const* d_in, const int* in_sizes, int n_in, void* d_out, int out_size, void* d_ws, size_t ws_size, hipStream_t stream) {
    static int grid = 0;
    if (grid == 0) {
        if (n_in != 13 || out_size != NTOK * DM || ws_size < WS_END) { fprintf(stderr, "kernel_launch: unexpected shapes (n_in %d, out %d, ws %zu)\n", n_in, out_size, ws_size); grid = -1; return; }
        int dev = 0, cus = 0, per_cu = 0;
        (void)hipGetDevice(&dev); (void)hipDeviceGetAttribute(&cus, hipDeviceAttributeMultiprocessorCount, dev);
        if (hipFuncSetAttribute((const void*)mk_fwd, hipFuncAttributeMaxDynamicSharedMemorySize, LDS_BYTES) != hipSuccess) { fprintf(stderr, "kernel_launch: hipFuncSetAttribute failed\n"); grid = -1; return; }
        if (hipOccupancyMaxActiveBlocksPerMultiprocessor(&per_cu, (const void*)mk_fwd, NWAVES * 64, LDS_BYTES) != hipSuccess || per_cu < 1) per_cu = 1;
        (void)hipGetLastError();
        if (cus <= 0) cus = 256;
        grid = cus * per_cu;
    }
    if (grid < 0) return;
    (void)hipMemsetAsync((char*)d_ws + WS_MOD, 0, CTL_ZERO_BYTES, stream);
    Args a{};
    a.x_prompt = (const float*)d_in[0]; a.x_sample = (const float*)d_in[1]; a.c_prompt = (const float*)d_in[2]; a.c_sample = (const float*)d_in[3];
    a.w_mod = (const float*)d_in[4]; a.b_mod = (const float*)d_in[5]; a.ln_g = (const float*)d_in[6]; a.ln_b = (const float*)d_in[7];
    a.w_in_a = (const float*)d_in[8]; a.w_out_a = (const float*)d_in[9]; a.w_in_b = (const float*)d_in[10]; a.w_out_b = (const float*)d_in[11]; a.sink_b = (const float*)d_in[12];
    a.out = (float*)d_out; a.ws = (unsigned char*)d_ws;
#if ONE_LAUNCH
    a.ph_lo = 0; a.ph_hi = N_PHASES;
    void* params[] = {&a};
    hipError_t e = hipLaunchCooperativeKernel((const void*)mk_fwd, dim3(grid), dim3(NWAVES * 64), params, LDS_BYTES, stream);
    if (e != hipSuccess) fprintf(stderr, "kernel_launch: cooperative launch failed: %s (grid %d)\n", hipGetErrorString(e), grid);
#else
    for (int k = 0; k < N_PHASES; ++k) { a.ph_lo = k; a.ph_hi = k + 1; hipLaunchKernelGGL(mk_fwd, dim3(grid), dim3(NWAVES * 64), LDS_BYTES, stream, a); }
#endif
}
```

```cpp
#include <hip/hip_runtime.h>
#include <hip/hip_cooperative_groups.h>
#include <cstdio>
#include <cstdint>
namespace cg = cooperative_groups;
__device__ __forceinline__ int hw_lane() { return (int)__builtin_amdgcn_mbcnt_hi(~0u, __builtin_amdgcn_mbcnt_lo(~0u, 0u)); }
namespace pg8 {
#define PG8_LAS __attribute__((address_space(3)))
typedef unsigned short bf16_t;
typedef short bf16x8 __attribute__((ext_vector_type(8)));
typedef float f32x4 __attribute__((ext_vector_type(4)));
typedef unsigned u32x4 __attribute__((ext_vector_type(4)));
constexpr int BM = 256, BK = 64, HALF = 128, HTB = HALF * BK * 2  , STAGE_BYTES = 8 * HTB, NXCD = 8, WGM = 8;

__host__ __device__ __forceinline__ int lds_byte(int r, int c) { const int st = (r >> 4) * 2 + (c >> 5), rr = r & 15, cc = c & 31, ob = rr * 64 + cc * 2; return st * 1024 + (ob ^ (((ob >> 9) & 1) << 5)); }
__host__ __device__ __forceinline__ void stage_rc(int b, int& R, int& C) { const int st = b / 1024, sb = b % 1024, swz = sb ^ (((sb >> 9) & 1) << 5); R = (st >> 1) * 16 + swz / 64; C = (st & 1) * 32 + (swz % 64) / 2; }
__host__ __device__ __forceinline__ int perm32(int rho) { const int n = rho >> 4, i = rho & 15; return 8 * (i >> 2) + 4 * n + (i & 3); }

struct Unit { int pm, pn; };
struct Gemm { const bf16_t* A; const bf16_t* Bt; int M, N, K; };

struct StaticOrder {
    int nM, nN, nwg, G, c;
    __host__ __device__ void init(int M, int N, int G_, int c_) { nM = M / BM; nN = N / BM; nwg = nM * nN; G = G_; c = c_; }
    __host__ __device__ bool next(int i, Unit& u) const {
        const long L = (long)i * G + c; if (L >= nwg) return false;
        int wgid = (int)L; { const int q = nwg / NXCD, r = nwg % NXCD, xcd = wgid % NXCD, off = wgid / NXCD; wgid = (xcd < r ? xcd * (q + 1) : r * (q + 1) + (xcd - r) * q) + off; }
        const int nig = WGM * nN, gid = wgid / nig, fm = gid * WGM, gsz = (nM - fm) < WGM ? (nM - fm) : WGM;
        u.pm = fm + ((wgid % nig) % gsz); u.pn = (wgid % nig) / gsz; return true;
    }
    __device__ __forceinline__ void a_ready(const Unit&) const {}
    __device__ __forceinline__ void done(const Unit&) const {}
};

__device__ __forceinline__ unsigned cvt_pk_bf16(float lo, float hi) { unsigned r; asm volatile("v_cvt_pk_bf16_f32 %0, %1, %2" : "=v"(r) : "v"(lo), "v"(hi)); return r; }
typedef float f32x2 __attribute__((ext_vector_type(2)));
__device__ __forceinline__ f32x2 gelu_pk(f32x2 v) {
    const f32x2 av = __builtin_elementwise_abs(v), d = av * 0.2316418882f + 1.0f;
    f32x2 t; t.x = __builtin_amdgcn_rcpf(d.x); t.y = __builtin_amdgcn_rcpf(d.y);
    f32x2 q = t * 0.5307027145f + (-0.7265760135f); q = q * t + 0.7107068705f; q = q * t + (-0.142248368f); q = q * t + 0.127414796f; q = q * t;
    const f32x2 s = (v * v) * (-0.72134752044f);
    f32x2 e; e.x = __builtin_amdgcn_exp2f(s.x); e.y = __builtin_amdgcn_exp2f(s.y);
    const f32x2 m = v * (q * e), r = v - m;
    f32x2 o; o.x = v.x < 0.f ? m.x : r.x; o.y = v.y < 0.f ? m.y : r.y; return o;
}

template <int ACT  > struct EpiBf16 {
    static constexpr bool PERM = true, AFTER_DRAIN = false; static_assert(ACT == 0 || ACT == 1, "EpiBf16: ACT is 0 (none) or 1 (gelu_pk)");
    bf16_t* O; int ldc; const float* bias; int split_cols; size_t split_stride; float scale0; int qmode;
    __device__ __forceinline__ void operator()(const f32x4 (&acc)[2][2][4][2], const Unit& u, int wr, int wc, int fr, int fq) const {
        const int row0 = u.pm * BM + wr * 64 + fr; int colt = u.pn * BM; bf16_t* base = O;
        float sc = 1.f; if (split_cols) { const int t = colt / split_cols; base += (size_t)t * split_stride; colt -= t * split_cols; if (t == 0) sc = scale0; }
        { const int blk = u.pn >> 2; if ((qmode == 1 && blk < 9 && (blk % 3) == 0) || (qmode == 2 && blk == 0)) sc = scale0; }
        const int col0 = colt + wc * 32 + 8 * fq, bcol0 = u.pn * BM + wc * 32 + 8 * fq;
        f32x4 bv[2][2];
#pragma unroll
        for (int bj = 0; bj < 2; ++bj)
#pragma unroll
            for (int n = 0; n < 2; ++n) bv[bj][n] = bias ? *(const f32x4*)(bias + bcol0 + bj * HALF + 4 * n) : (f32x4){0.f, 0.f, 0.f, 0.f};
#pragma unroll
        for (int ai = 0; ai < 2; ++ai)
#pragma unroll
            for (int m = 0; m < 4; ++m) { bf16_t* rowp = base + (size_t)(row0 + ai * HALF + m * 16) * ldc + col0;
#pragma unroll
                for (int bj = 0; bj < 2; ++bj) { f32x4 v0 = acc[ai][bj][m][0] + bv[bj][0], v1 = acc[ai][bj][m][1] + bv[bj][1];
                    if (ACT == 1) { f32x2 a = gelu_pk((f32x2){v0[0], v0[1]}), b = gelu_pk((f32x2){v0[2], v0[3]}), c = gelu_pk((f32x2){v1[0], v1[1]}), d = gelu_pk((f32x2){v1[2], v1[3]});
                        v0 = (f32x4){a.x, a.y, b.x, b.y}; v1 = (f32x4){c.x, c.y, d.x, d.y}; }
                    v0 = v0 * sc; v1 = v1 * sc; u32x4 w; w.x = cvt_pk_bf16(v0[0], v0[1]); w.y = cvt_pk_bf16(v0[2], v0[3]); w.z = cvt_pk_bf16(v1[0], v1[1]); w.w = cvt_pk_bf16(v1[2], v1[3]);
                    *(u32x4*)(rowp + bj * HALF) = w; } }
    }
};
struct EpiRes {
    static constexpr bool PERM = false, AFTER_DRAIN = false;
    const float* xa; const float* xb; float* out; const float* gate_base; float alpha;
    __device__ __forceinline__ void operator()(const f32x4 (&acc)[2][2][4][2], const Unit& u, int wr, int wc, int fr, int fq) const {
        const int rowt = u.pm * BM;
        const int b = rowt < 32768 ? (rowt >> 13) : 4 + ((rowt - 32768) >> 12);
        const float* xs = rowt < 32768 ? xa + (size_t)rowt * 1024 : xb + (size_t)(rowt - 32768) * 1024;
        float* os = out + (size_t)rowt * 1024;
        const float* gp = gate_base + b * 3072;
        const int col0 = u.pn * BM + wc * 32 + 4 * fq;
        f32x4 gv[2][2];
#pragma unroll
        for (int bj = 0; bj < 2; ++bj)
#pragma unroll
            for (int n = 0; n < 2; ++n) gv[bj][n] = *(const f32x4*)(gp + col0 + bj * HALF + n * 16);
#pragma unroll
        for (int ai = 0; ai < 2; ++ai)
#pragma unroll
            for (int m = 0; m < 4; ++m) { const size_t off = (size_t)(wr * 64 + fr + ai * HALF + m * 16) * 1024 + col0;
#pragma unroll
                for (int bj = 0; bj < 2; ++bj)
#pragma unroll
                    for (int n = 0; n < 2; ++n) { const f32x4 xv = *(const f32x4*)(xs + off + bj * HALF + n * 16);
                        *(f32x4*)(os + off + bj * HALF + n * 16) = xv * alpha + gv[bj][n] * acc[ai][bj][m][n]; } }
    }
};
template <class Epi, class Sched, bool ALIGN_EPI = false, bool SP2 = false>
__device__ __forceinline__ void gemm_phase(PG8_LAS unsigned char* lds, const Gemm g, const Sched& S, const Epi& E, int wave_in) {
    int tid_l = wave_in * 64 + hw_lane(); asm volatile("" : "+v"(tid_l));
    const int tid = tid_l, wid = __builtin_amdgcn_readfirstlane(tid >> 6), lane = tid & 63, wr = wid >> 2, wc = wid & 3, fr = lane & 15, fq = lane >> 4;
    const int K = g.K, nt = K / BK;
    unsigned voffA[2], voffB[2];
#pragma unroll
    for (int i = 0; i < 2; ++i) { int R, C; stage_rc(tid * 16 + i * 8192, R, C); const int Rb = Epi::PERM ? ((R & ~31) + perm32(R & 31)) : R;
        voffA[i] = (unsigned)(R * K + C) * 2u; voffB[i] = (unsigned)(Rb * K + C) * 2u; }
    const size_t kstep = (size_t)(BK * 2);
    const size_t hstep = (size_t)HALF * K * 2;
    const size_t tstep = 2 * hstep;
    const unsigned ldsw = (unsigned)wid * 1024u;
    const int aoff = lds_byte(wr * 64 + fr, fq * 8), boff = lds_byte(wc * 32 + fr, fq * 8);
#define PG8_SA(b, h) (((b) * 2 + (h)) * HTB)
#define PG8_SB(b, h) ((4 + (b) * 2 + (h)) * HTB)
#define PG8_STAGE(bufoff, gbase, voff) do { _Pragma("unroll") for (int _i = 0; _i < 2; ++_i) \
        __builtin_amdgcn_global_load_lds((const unsigned*)((const char*)(gbase) + (voff)[_i]), (PG8_LAS unsigned*)(lds + (bufoff) + ldsw + _i * 8192), 16, 0, 0); } while (0)
#define PG8_LDA(dst, b, h) do { _Pragma("unroll") for (int m = 0; m < 4; ++m) _Pragma("unroll") for (int k = 0; k < 2; ++k) dst[m][k] = *(const PG8_LAS bf16x8*)(lds + PG8_SA(b, h) + aoff + m * 2048 + k * 1024); } while (0)
#define PG8_LDB(dst, b, h) do { _Pragma("unroll") for (int n = 0; n < 2; ++n) _Pragma("unroll") for (int k = 0; k < 2; ++k) dst[n][k] = *(const PG8_LAS bf16x8*)(lds + PG8_SB(b, h) + boff + n * 2048 + k * 1024); } while (0)
#define PG8_MMA(ai, bj, At, Bt) do { __builtin_amdgcn_s_setprio(1); _Pragma("unroll") for (int m = 0; m < 4; ++m) _Pragma("unroll") for (int n = 0; n < 2; ++n) _Pragma("unroll") for (int k = 0; k < 2; ++k) \
        acc[ai][bj][m][n] = __builtin_amdgcn_mfma_f32_16x16x32_bf16(Bt[n][k], At[m][k], acc[ai][bj][m][n], 0, 0, 0); __builtin_amdgcn_s_setprio(0); } while (0)
#define PG8_WAIT_V(n) asm volatile("s_waitcnt vmcnt(" #n ")" ::: "memory")
#define PG8_WAIT_L(n) asm volatile("s_waitcnt lgkmcnt(" #n ")" ::: "memory")
#define PG8_BAR __builtin_amdgcn_s_barrier()
#define PG8_SCHED __builtin_amdgcn_sched_barrier(0)
    Unit cur, nxt; int ui = 0;
    if (!S.next(0, cur)) return;
    f32x4 acc[2][2][4][2];
#pragma unroll
    for (int a = 0; a < 2; ++a)
#pragma unroll
        for (int b = 0; b < 2; ++b)
#pragma unroll
            for (int m = 0; m < 4; ++m)
#pragma unroll
                for (int n = 0; n < 2; ++n) acc[a][b][m][n] = (f32x4){0.f, 0.f, 0.f, 0.f};
    bf16x8 At[4][2], B0[2][2], B1[2][2];
    const char* cA = (const char*)g.A + (size_t)cur.pm * tstep; const char* cB = (const char*)g.Bt + (size_t)cur.pn * tstep;
    S.a_ready(cur);
    if constexpr (SP2) {
        PG8_STAGE(PG8_SB(0, 0), cB, voffB); PG8_STAGE(PG8_SB(0, 1), cB + hstep, voffB); PG8_STAGE(PG8_SA(0, 0), cA, voffA); PG8_STAGE(PG8_SA(0, 1), cA + hstep, voffA);
        if (wr == 1) PG8_BAR;
        PG8_WAIT_V(2); PG8_BAR;
        PG8_STAGE(PG8_SB(1, 0), cB + kstep, voffB); PG8_STAGE(PG8_SA(1, 0), cA + kstep, voffA); PG8_STAGE(PG8_SB(1, 1), cB + hstep + kstep, voffB);
        PG8_WAIT_V(6); PG8_BAR;
    } else {
        PG8_STAGE(PG8_SB(0, 0), cB, voffB); PG8_STAGE(PG8_SA(0, 0), cA, voffA); PG8_STAGE(PG8_SB(0, 1), cB + hstep, voffB); PG8_STAGE(PG8_SA(0, 1), cA + hstep, voffA);
        if (wr == 1) PG8_BAR;
        PG8_WAIT_V(4); PG8_BAR;
        PG8_STAGE(PG8_SB(1, 0), cB + kstep, voffB); PG8_STAGE(PG8_SA(1, 0), cA + kstep, voffA); PG8_STAGE(PG8_SB(1, 1), cB + hstep + kstep, voffB);
        PG8_WAIT_V(6); PG8_BAR;
    }
    for (;;) {
        const bool has_next = S.next(ui + 1, nxt);
        const char* nA = has_next ? (const char*)g.A + (size_t)nxt.pm * tstep : cA; const char* nB = has_next ? (const char*)g.Bt + (size_t)nxt.pn * tstep : cB;
        for (int t = 0; t < nt; t += 2) {
            const bool last = (t == nt - 2);
            const char* a1 = cA + (size_t)(t + 1) * kstep;
            const char* a2 = last ? nA : cA + (size_t)(t + 2) * kstep; const char* b2 = last ? nB : cB + (size_t)(t + 2) * kstep;
            const char* a3 = a2 + kstep; const char* b3 = b2 + kstep;
            if (last && has_next) S.a_ready(nxt);
            if constexpr (SP2) {
            PG8_LDB(B0, 0, 0); PG8_LDB(B1, 0, 1); PG8_SCHED; PG8_LDA(At, 0, 0); PG8_STAGE(PG8_SA(1, 1), a1 + hstep, voffA);
            PG8_WAIT_V(8); PG8_WAIT_L(0); PG8_BAR; PG8_MMA(0, 0, At, B0); PG8_MMA(0, 1, At, B1); PG8_BAR; PG8_SCHED;
            PG8_LDA(At, 0, 1); PG8_STAGE(PG8_SB(0, 0), b2, voffB); PG8_STAGE(PG8_SB(0, 1), b2 + hstep, voffB); PG8_STAGE(PG8_SA(0, 0), a2, voffA);
            PG8_WAIT_V(8); PG8_WAIT_L(0); PG8_BAR; PG8_MMA(1, 0, At, B0); PG8_MMA(1, 1, At, B1); PG8_BAR; PG8_SCHED;
            PG8_LDB(B0, 1, 0); PG8_LDB(B1, 1, 1); PG8_SCHED; PG8_LDA(At, 1, 0); PG8_STAGE(PG8_SA(0, 1), a2 + hstep, voffA);
            PG8_WAIT_V(8); PG8_WAIT_L(0); PG8_BAR; PG8_MMA(0, 0, At, B0); PG8_MMA(0, 1, At, B1); PG8_BAR; PG8_SCHED;
            PG8_LDA(At, 1, 1); PG8_STAGE(PG8_SB(1, 0), b3, voffB); PG8_STAGE(PG8_SB(1, 1), b3 + hstep, voffB); PG8_STAGE(PG8_SA(1, 0), a3, voffA);
            PG8_WAIT_V(8); PG8_WAIT_L(0); PG8_BAR; PG8_MMA(1, 0, At, B0); PG8_MMA(1, 1, At, B1); PG8_BAR; PG8_SCHED;
            } else {
            PG8_LDB(B0, 0, 0); PG8_SCHED; PG8_LDA(At, 0, 0); PG8_STAGE(PG8_SA(1, 1), a1 + hstep, voffA);
            PG8_WAIT_L(8); PG8_BAR; PG8_WAIT_L(0); PG8_MMA(0, 0, At, B0); PG8_BAR; PG8_SCHED;
            PG8_LDB(B1, 0, 1); PG8_STAGE(PG8_SB(0, 0), b2, voffB);
            PG8_BAR; PG8_WAIT_L(0); PG8_MMA(0, 1, At, B1); PG8_BAR;
            PG8_LDA(At, 0, 1); PG8_STAGE(PG8_SA(0, 0), a2, voffA);
            PG8_BAR; PG8_WAIT_L(0); PG8_MMA(1, 0, At, B0); PG8_BAR; PG8_SCHED;
            PG8_STAGE(PG8_SB(0, 1), b2 + hstep, voffB);
            PG8_WAIT_V(6); PG8_BAR; PG8_MMA(1, 1, At, B1); PG8_BAR;
            PG8_LDB(B0, 1, 0); PG8_SCHED; PG8_LDA(At, 1, 0); PG8_STAGE(PG8_SA(0, 1), a2 + hstep, voffA);
            PG8_WAIT_L(8); PG8_BAR; PG8_WAIT_L(0); PG8_MMA(0, 0, At, B0); PG8_BAR; PG8_SCHED;
            PG8_LDB(B1, 1, 1); PG8_STAGE(PG8_SB(1, 0), b3, voffB);
            PG8_BAR; PG8_WAIT_L(0); PG8_MMA(0, 1, At, B1); PG8_BAR;
            PG8_LDA(At, 1, 1); PG8_STAGE(PG8_SA(1, 0), a3, voffA);
            PG8_BAR; PG8_WAIT_L(0); PG8_MMA(1, 0, At, B0); PG8_BAR; PG8_SCHED;
            PG8_STAGE(PG8_SB(1, 1), b3 + hstep, voffB);
            PG8_WAIT_V(6); PG8_BAR; PG8_MMA(1, 1, At, B1); PG8_BAR;
            }
        }
        if constexpr (ALIGN_EPI) { if (wr == 0) PG8_BAR; }
        if constexpr (!Epi::AFTER_DRAIN) { E(acc, cur, wr, wc, fr, fq); S.done(cur); }
        if (!has_next) break;
#pragma unroll
        for (int a = 0; a < 2; ++a)
#pragma unroll
            for (int b = 0; b < 2; ++b)
#pragma unroll
                for (int m = 0; m < 4; ++m)
#pragma unroll
                    for (int n = 0; n < 2; ++n) acc[a][b][m][n] = (f32x4){0.f, 0.f, 0.f, 0.f};
        cur = nxt; cA = nA; cB = nB; ++ui;
        if constexpr (ALIGN_EPI) { if (wr == 1) PG8_BAR; }
    }
    PG8_WAIT_V(0);
    if constexpr (!ALIGN_EPI) { if (wr == 0) PG8_BAR; }
    PG8_BAR;
    if constexpr (Epi::AFTER_DRAIN) { E.fused(acc, cur, wr, wc, fr, fq, lds, wid, lane); S.done(cur); }
#undef PG8_SA
#undef PG8_SB
#undef PG8_STAGE
#undef PG8_LDA
#undef PG8_LDB
#undef PG8_MMA
#undef PG8_WAIT_V
#undef PG8_WAIT_L
#undef PG8_BAR
#undef PG8_SCHED
}
}
constexpr int DM = 1024, NTOK = 65536, NPROMPT = 32768, NB = 12, DEPTH = 4;
constexpr int IN_A = 10240, IN_B = 2560;
constexpr int CH_A = 8192, NCH_A = 8, CH_B = 32768, NCH_B = 2;
constexpr float LN_EPS = 1e-5f;
constexpr float LOG2E = 1.4426950408889634f;
constexpr float CSCALE = 0.125f * LOG2E;
constexpr size_t MiB = 1u << 20;
constexpr size_t WS_MOD = 0, CTL_ZERO_BYTES = 1 * MiB;
constexpr size_t WS_BAR = 640 * 1024;
constexpr size_t WS_WINA = 2 * MiB;
constexpr size_t WS_WOUTA = 42 * MiB;
constexpr size_t WS_WINB = 46 * MiB;
constexpr size_t WS_WOUTB = 56 * MiB;
constexpr size_t WS_U = 64 * MiB;
constexpr size_t WS_ATT = 192 * MiB;
constexpr size_t WS_PROJ = 320 * MiB;
constexpr size_t WS_END = 480 * MiB;
constexpr int LDS_BYTES = 147456;
constexpr int NWAVES = 8;

#define LAS __attribute__((address_space(3)))
typedef unsigned short bf16_t;
typedef short bf16x8 __attribute__((ext_vector_type(8)));
typedef short s16x4 __attribute__((ext_vector_type(4)));
typedef float f32x4 __attribute__((ext_vector_type(4)));
typedef float f32x2 __attribute__((ext_vector_type(2)));
typedef unsigned u32x4 __attribute__((ext_vector_type(4)));
typedef unsigned u32x2 __attribute__((ext_vector_type(2)));
typedef __bf16 bf16x2_t __attribute__((ext_vector_type(2)));
typedef short v4i16_t __attribute__((ext_vector_type(4)));

__device__ __forceinline__ unsigned cvtpk(float lo, float hi) { f32x2 v = {lo, hi}; bf16x2_t b = __builtin_convertvector(v, bf16x2_t); return __builtin_bit_cast(unsigned, b); }
__device__ __forceinline__ float bf_lo(unsigned w) { return __uint_as_float(w << 16); }
__device__ __forceinline__ float bf_hi(unsigned w) { return __uint_as_float(w & 0xffff0000u); }
__device__ __forceinline__ float silu_f(float z) { return z / (1.f + __expf(-z)); }
__device__ __forceinline__ int batch_of_row(int row) { return row < NPROMPT ? (row >> 13) : 4 + ((row - NPROMPT) >> 12); }
__device__ __forceinline__ float wave_sum(float v) {
#pragma unroll
    for (int o = 1; o < 64; o <<= 1) v += __shfl_xor(v, o);
    return v;
}

#define XB_TMO      128
#define XB_XCNT(j)  (256  + 64 * (j))
#define XB_XSUB(j)  (1280 + 64 * (j))
#define XB_XGEN(j)  (2304 + 64 * (j))
#define XB_TOP      3328
#define XB_TOPGEN   3392
#define XCD_BAR_WORDS 3456
#define XB_SPIN_CAP (1u << 18)

__device__ __forceinline__ unsigned xb_ld(unsigned* p)              { return __hip_atomic_load(p, __ATOMIC_RELAXED, __HIP_MEMORY_SCOPE_AGENT); }
__device__ __forceinline__ unsigned xb_add(unsigned* p, unsigned v) { return __hip_atomic_fetch_add(p, v, __ATOMIC_RELAXED, __HIP_MEMORY_SCOPE_AGENT); }
__device__ __forceinline__ unsigned xb_xcc_id() { return (unsigned)__builtin_amdgcn_s_getreg((3 << 11) | 20) & 0xFu; }
#define XB_SPIN(cond, bar) do { unsigned _sp = 0; while (cond) { __builtin_amdgcn_s_sleep(1); \
    if ((++_sp & 255u) == 0u) { if (xb_ld(&(bar)[XB_TMO])) break; if (_sp > XB_SPIN_CAP) { atomicAdd(&(bar)[XB_TMO], 1u); break; } } } } while (0)

struct XcdBarrier {
    unsigned* bar; unsigned x;
    volatile LAS unsigned* st;
};

__device__ __forceinline__ XcdBarrier xcd_barrier_post(unsigned* bar, volatile LAS unsigned* st) {
    XcdBarrier b; b.bar = bar; b.x = xb_xcc_id(); b.st = st;
    if (threadIdx.x == 0) (void)xb_add(&bar[XB_XCNT(b.x)], 1u);
    return b;
}
__device__ __forceinline__ void xcd_barrier_complete(unsigned* bar, unsigned x, unsigned& nloc, unsigned& nx) {
    const unsigned G = gridDim.x * gridDim.y * gridDim.z;
    unsigned sum, cnt, mine, sp = 0u;
    for (;;) {
        sum = 0u; cnt = 0u; mine = 0u;
#pragma unroll
        for (unsigned j = 0; j < 16; ++j) { const unsigned c = xb_ld(&bar[XB_XCNT(j)]); sum += c; cnt += (c > 0u) ? 1u : 0u; }
        mine = xb_ld(&bar[XB_XCNT(x)]);
        if (sum == G) break;
        __builtin_amdgcn_s_sleep(1);
        if ((++sp & 255u) == 0u) { if (xb_ld(&bar[XB_TMO])) break; if (sp > XB_SPIN_CAP) { atomicAdd(&bar[XB_TMO], 1u); break; } }
    }
    nloc = mine > 0u ? mine : 1u; nx = cnt > 0u ? cnt : 1u;
}

__device__ __forceinline__ void xcd_barrier(const XcdBarrier& b) {
    asm volatile("s_waitcnt vmcnt(0)" ::: "memory");
    __syncthreads();
    if (threadIdx.x == 0) {
        unsigned* bar = b.bar;
        __builtin_amdgcn_s_waitcnt(0);
        unsigned nloc = b.st[0], nx = b.st[1];
        if (nloc == 0u) { xcd_barrier_complete(bar, b.x, nloc, nx); b.st[0] = nloc; b.st[1] = nx; }
        const unsigned old = xb_add(&bar[XB_XSUB(b.x)], 1u);
        const unsigned gen = old / nloc;
        if (old + 1u == (gen + 1u) * nloc) {
            __builtin_amdgcn_fence(__ATOMIC_RELEASE, "agent");
            asm volatile("s_waitcnt vmcnt(0)" ::: "memory");
            const unsigned og = xb_add(&bar[XB_TOP], 1u);
            const unsigned tg = og / nx;
            if (og + 1u == (tg + 1u) * nx) xb_add(&bar[XB_TOPGEN], 1u);
            else XB_SPIN(xb_ld(&bar[XB_TOPGEN]) == tg, bar);
            __builtin_amdgcn_fence(__ATOMIC_ACQUIRE, "agent");
            xb_add(&bar[XB_XGEN(b.x)], 1u);
            asm volatile("s_waitcnt vmcnt(0)" ::: "memory");
        } else {
            XB_SPIN(xb_ld(&bar[XB_XGEN(b.x)]) == gen, bar);
            __builtin_amdgcn_fence(__ATOMIC_ACQUIRE, "agent");
            asm volatile("s_waitcnt vmcnt(0)" ::: "memory");
        }
    }
    __syncthreads();
}

__device__ __forceinline__ float q4_max(float v) {
    auto r = __builtin_amdgcn_permlane16_swap(__float_as_uint(v), __float_as_uint(v), false, false); v = fmaxf(__uint_as_float(r[0]), __uint_as_float(r[1]));
    auto q = __builtin_amdgcn_permlane32_swap(__float_as_uint(v), __float_as_uint(v), false, false); return fmaxf(__uint_as_float(q[0]), __uint_as_float(q[1]));
}
__device__ __forceinline__ float q4_sum(float v) {
    auto r = __builtin_amdgcn_permlane16_swap(__float_as_uint(v), __float_as_uint(v), false, false); v = __uint_as_float(r[0]) + __uint_as_float(r[1]);
    auto q = __builtin_amdgcn_permlane32_swap(__float_as_uint(v), __float_as_uint(v), false, false); return __uint_as_float(q[0]) + __uint_as_float(q[1]);
}
__device__ __forceinline__ bf16x8 sm_soft(const f32x4 (&sa)[2], float rb, float lo, float hi, float slope2, bool fast, float& m, float& l, f32x4 (&o)[4]) {
    float sc[8];
    if (fast) {
#pragma unroll
        for (int t_ = 0; t_ < 2; ++t_)
#pragma unroll
            for (int r = 0; r < 4; ++r) sc[4 * t_ + r] = fmaf(-slope2, fabsf(rb + (float)(16 * t_ + r)), sa[t_][r]);
    } else {
#pragma unroll
        for (int t_ = 0; t_ < 2; ++t_)
#pragma unroll
            for (int r = 0; r < 4; ++r) {
                const float relf = rb + (float)(16 * t_ + r);
                const float v = fmaf(-slope2, fabsf(relf), sa[t_][r]);
                sc[4 * t_ + r] = (relf >= lo && relf <= hi) ? v : -1e30f;
            }
    }
    float mx = fmaxf(fmaxf(fmaxf(sc[0], sc[1]), fmaxf(sc[2], sc[3])), fmaxf(fmaxf(sc[4], sc[5]), fmaxf(sc[6], sc[7])));
    mx = q4_max(mx);
    if (__any(mx > m + 8.f)) {
        const float mn = fmaxf(m, mx), alpha = __builtin_amdgcn_exp2f(m - mn); m = mn;
        l = l * alpha;
#pragma unroll
        for (int n = 0; n < 4; ++n) o[n] = o[n] * alpha;
    }
    float ps = 0.f;
#pragma unroll
    for (int k = 0; k < 8; ++k) { sc[k] = __builtin_amdgcn_exp2f(sc[k] - m); ps += sc[k]; }
    l += ps;
    u32x4 pw; pw.x = cvtpk(sc[0], sc[1]); pw.y = cvtpk(sc[2], sc[3]); pw.z = cvtpk(sc[4], sc[5]); pw.w = cvtpk(sc[6], sc[7]);
    return __builtin_bit_cast(bf16x8, pw);
}
__device__ __forceinline__ void load_vfrag(LAS unsigned char* vb, bf16x8 (&va)[4]) {
#pragma unroll
    for (int n = 0; n < 4; ++n) {
        const s16x4 v0 = __builtin_bit_cast(s16x4, __builtin_amdgcn_ds_read_tr16_b64_v4i16((LAS v4i16_t*)(vb + n * 32)));
        const s16x4 v1 = __builtin_bit_cast(s16x4, __builtin_amdgcn_ds_read_tr16_b64_v4i16((LAS v4i16_t*)(vb + n * 32 + 2560)));
        va[n] = (bf16x8){v0[0], v0[1], v0[2], v0[3], v1[0], v1[1], v1[2], v1[3]};
    }
}
__device__ __forceinline__ void pv_step(const bf16x8 (&va)[4], bf16x8 pb, f32x4 (&o)[4]) {
#pragma unroll
    for (int n = 0; n < 4; ++n) o[n] = __builtin_amdgcn_mfma_f32_16x16x32_bf16(va[n], pb, o[n], 0, 0, 0);
}
template <int D_, int NS, int QSTEP, int NSTEPS, int NI>
__device__ __forceinline__ void group_pass(const bf16_t* __restrict__ Pq, const bf16_t* __restrict__ Pk, const bf16_t* __restrict__ Pv, int pitch, int S, const int (&t0)[NI], const int (&tq)[NI],
                                           float slope2, LAS unsigned char* vl  , int lane, float (&m)[NI], float (&l)[NI], f32x4 (&o)[NI][4]) {
    const int i = lane & 15, g = lane >> 4;
    bf16x8 qb[NI][2]; float lo[NI], hi[NI];
#pragma unroll
    for (int x = 0; x < NI; ++x) {
#pragma unroll
        for (int s = 0; s < 2; ++s) qb[x][s] = *(const bf16x8*)((const char*)Pq + (unsigned)(tq[x] * pitch + 8 * g) * 2u + 64 * s);
        const int lo_i = -(tq[x] / D_), hi_i = (S - 1 - tq[x]) / D_;
        lo[x] = (float)(lo_i > -NS ? lo_i : -NS); hi[x] = (float)(hi_i < NS ? hi_i : NS);
    }
    const float relbase = (float)(-NS + 4 * g - QSTEP * i);
    const int vk = lane >> 3, vc = lane & 7;
    LAS unsigned char* vw = vl + vk * 160 + vc * 16;
    LAS unsigned char* vb = vl + (4 * g + ((lane & 15) >> 2)) * 160 + 8 * (lane & 3);
    bf16x8 kn[NI][2][2]; u32x4 vn[NI][4];
    int kof[NI], vof[NI];
#pragma unroll
    for (int x = 0; x < NI; ++x) { kof[x] = ((t0[x] + D_ * (i - NS)) * pitch + 8 * g) * 2; vof[x] = ((t0[x] + D_ * (vk - NS)) * pitch + 8 * vc) * 2; }
    const int sstride = 32 * D_ * pitch * 2, tstride = 16 * D_ * pitch * 2, cstride = 8 * D_ * pitch * 2;
#define ATT_INR(x, st_) (t0[x] + D_ * (32 * (st_) - NS) >= 0 && t0[x] + D_ * (32 * (st_) + 31 - NS) <= S - 1)
#define ATT_LOAD(st_) do { _Pragma("unroll") for (int x = 0; x < NI; ++x) { \
        if (ATT_INR(x, st_)) { \
            _Pragma("unroll") for (int t_ = 0; t_ < 2; ++t_) _Pragma("unroll") for (int s = 0; s < 2; ++s) kn[x][t_][s] = *(const bf16x8*)((const char*)Pk + (unsigned)(kof[x] + (st_) * sstride + t_ * tstride) + 64 * s); \
            _Pragma("unroll") for (int c = 0; c < 4; ++c) vn[x][c] = *(const u32x4*)((const char*)Pv + (unsigned)(vof[x] + (st_) * sstride + c * cstride)); \
        } else { \
        _Pragma("unroll") for (int t_ = 0; t_ < 2; ++t_) { int tk = t0[x] + D_ * (32 * (st_) + 16 * t_ + i - NS); tk = tk < 0 ? 0 : (tk > S - 1 ? S - 1 : tk); \
            const unsigned ko = (unsigned)(tk * pitch + 8 * g) * 2u; \
            _Pragma("unroll") for (int s = 0; s < 2; ++s) kn[x][t_][s] = *(const bf16x8*)((const char*)Pk + ko + 64 * s); } \
        _Pragma("unroll") for (int c = 0; c < 4; ++c) { int tk = t0[x] + D_ * (32 * (st_) + 8 * c + vk - NS); tk = tk < 0 ? 0 : (tk > S - 1 ? S - 1 : tk); \
            vn[x][c] = *(const u32x4*)((const char*)Pv + (unsigned)(tk * pitch + 8 * vc) * 2u); } } } } while (0)
    ATT_LOAD(0);
#pragma unroll 1
    for (int st = 0; st < NSTEPS; ++st) {
        f32x4 sa[NI][2]; bf16x8 va[NI][4]; bf16x8 pb[NI];
        const bool interior = (32 * st - NS - 15 * QSTEP >= -NS) && (32 * st + 31 - NS <= NS);
        bool fast[NI];
#pragma unroll
        for (int x = 0; x < NI; ++x) {
            fast[x] = interior && ATT_INR(x, st);
#pragma unroll
            for (int c = 0; c < 4; ++c) *(LAS u32x4*)(vw + x * 5120 + c * 1280) = vn[x][c];
#pragma unroll
            for (int t_ = 0; t_ < 2; ++t_) {
                sa[x][t_] = __builtin_amdgcn_mfma_f32_16x16x32_bf16(kn[x][t_][0], qb[x][0], (f32x4){0.f, 0.f, 0.f, 0.f}, 0, 0, 0);
                sa[x][t_] = __builtin_amdgcn_mfma_f32_16x16x32_bf16(kn[x][t_][1], qb[x][1], sa[x][t_], 0, 0, 0);
            }
        }
        if (st + 1 < NSTEPS) ATT_LOAD(st + 1);
#pragma unroll
        for (int x = 0; x < NI; ++x) pb[x] = sm_soft(sa[x], relbase + (float)(32 * st), lo[x], hi[x], slope2, fast[x], m[x], l[x], o[x]);
#pragma unroll
        for (int x = 0; x < NI; ++x) load_vfrag(vb + x * 5120, va[x]);
#pragma unroll
        for (int x = 0; x < NI; ++x) pv_step(va[x], pb[x], o[x]);
    }
#undef ATT_INR
#undef ATT_LOAD
}
constexpr int KROW = 144, VROW = 160, WROWS = 416;
constexpr int WIN_K = 0, WIN_V = WROWS * KROW, WIN_BYTES = WROWS * (KROW + VROW);
template <int NS, int QSTEP, int NSTEPS, int NI, bool SHARED>
__device__ __forceinline__ void group_pass_lds(const bf16_t* const (&Pq)[NI], int pitch, int S, const int (&tq)[NI], const float (&slope2)[NI], LAS unsigned char* win, const int (&row0)[NI], const int (&tb)[NI],
                                               int lane, float (&m)[NI], float (&l)[NI], f32x4 (&o)[NI][4]) {
    const int i = lane & 15, g = lane >> 4;
    bf16x8 qb[NI][2]; float lo[NI], hi[NI];
    LAS unsigned char* kb[NI]; LAS unsigned char* vb[NI];
#pragma unroll
    for (int x = 0; x < NI; ++x) {
#pragma unroll
        for (int s = 0; s < 2; ++s) qb[x][s] = *(const bf16x8*)((const char*)Pq[x] + (unsigned)(tq[x] * pitch + 8 * g) * 2u + 64 * s);
        const int lo_i = -tq[x], hi_i = S - 1 - tq[x];
        lo[x] = (float)(lo_i > -NS ? lo_i : -NS); hi[x] = (float)(hi_i < NS ? hi_i : NS);
        kb[x] = win + WIN_K + (row0[x] + i) * KROW + 16 * g;
        vb[x] = win + WIN_V + (row0[x] + 4 * g + ((lane & 15) >> 2)) * VROW + 8 * (lane & 3);
    }
    const float relbase = (float)(-NS + 4 * g - QSTEP * i);
#pragma unroll 1
    for (int st = 0; st < NSTEPS; ++st) {
        f32x4 sa[NI][2]; bf16x8 va[NI][4]; bf16x8 pb[NI];
        const bool interior = (32 * st - NS - 15 * QSTEP >= -NS) && (32 * st + 31 - NS <= NS);
        bool fast[NI];
#pragma unroll
        for (int x = 0; x < NI; ++x) fast[x] = interior && (tb[x] + 32 * st - NS >= 0) && (tb[x] + 32 * st + 31 - NS <= S - 1);
#pragma unroll
        for (int x = 0; x < NI; ++x) {
            if (!SHARED || x == 0) {
                bf16x8 kf[2][2];
#pragma unroll
                for (int t_ = 0; t_ < 2; ++t_) { kf[t_][0] = *(LAS bf16x8*)(kb[x] + (32 * st + 16 * t_) * KROW); kf[t_][1] = *(LAS bf16x8*)(kb[x] + (32 * st + 16 * t_) * KROW + 64); }
                if (SHARED) load_vfrag(vb[x] + 32 * st * VROW, va[x]);
#pragma unroll
                for (int y = 0; y < NI; ++y) if (y == x || (SHARED && x == 0)) {
#pragma unroll
                    for (int t_ = 0; t_ < 2; ++t_) {
                        sa[y][t_] = __builtin_amdgcn_mfma_f32_16x16x32_bf16(kf[t_][0], qb[y][0], (f32x4){0.f, 0.f, 0.f, 0.f}, 0, 0, 0);
                        sa[y][t_] = __builtin_amdgcn_mfma_f32_16x16x32_bf16(kf[t_][1], qb[y][1], sa[y][t_], 0, 0, 0);
                    }
                }
            }
        }
#pragma unroll
        for (int x = 0; x < NI; ++x) pb[x] = sm_soft(sa[x], relbase + (float)(32 * st), lo[x], hi[x], slope2[x], fast[x], m[x], l[x], o[x]);
        if (!SHARED) {
#pragma unroll
            for (int x = 0; x < NI; ++x) load_vfrag(vb[x] + 32 * st * VROW, va[x]);
        }
#pragma unroll
        for (int x = 0; x < NI; ++x) pv_step(va[SHARED ? 0 : x], pb[x], o[x]);
    }
}
__device__ __forceinline__ void stage_window(const bf16_t* __restrict__ Pk, const bf16_t* __restrict__ Pv, int pitch, int S, int w0, LAS unsigned char* lds, int tid) {
    u32x4 kr[7], vr[7];
#pragma unroll
    for (int j = 0; j < 7; ++j) { const int e = tid + 512 * j, row = e >> 3, ch = e & 7; int tk = w0 + row; tk = tk < 0 ? 0 : (tk > S - 1 ? S - 1 : tk);
        if (e < WROWS * 8) { const unsigned off = (unsigned)(tk * pitch + ch * 8) * 2u; kr[j] = *(const u32x4*)((const char*)Pk + off); vr[j] = *(const u32x4*)((const char*)Pv + off); } }
#pragma unroll
    for (int j = 0; j < 7; ++j) { const int e = tid + 512 * j, row = e >> 3, ch = e & 7;
        if (e < WROWS * 8) { *(LAS u32x4*)(lds + WIN_K + row * KROW + ch * 16) = kr[j]; *(LAS u32x4*)(lds + WIN_V + row * VROW + ch * 16) = vr[j]; } }
}

__device__ __forceinline__ void attn_store(const bf16_t* __restrict__ Pz, int pitch, int tq, bf16_t* __restrict__ orow0  , int lane, float l, const f32x4 (&o)[4]) {
    const int g = lane >> 4;
    const float inv = 1.f / q4_sum(l);
#pragma unroll
    for (int n = 0; n < 4; ++n) {
        const u32x2 zw = *(const u32x2*)(Pz + (size_t)tq * pitch + 16 * n + 4 * g);
        const float a0 = o[n][0] * inv * silu_f(bf_lo(zw.x)), a1 = o[n][1] * inv * silu_f(bf_hi(zw.x));
        const float a2 = o[n][2] * inv * silu_f(bf_lo(zw.y)), a3 = o[n][3] * inv * silu_f(bf_hi(zw.y));
        u32x2 w; w.x = cvtpk(a0, a1); w.y = cvtpk(a2, a3);
        *(u32x2*)(orow0 + (size_t)tq * 1024 + 16 * n + 4 * g) = w;
    }
}

__device__ __forceinline__ void attn_a_phase(const bf16_t* P, bf16_t* A, int S, LAS unsigned char* lds, int wave, int lane_in, int tid_in) {
    int lane = lane_in, tid = tid_in; asm volatile("" : "+v"(lane), "+v"(tid));
    LAS unsigned char* vl = lds + wave * 10240;
    for (int bu = blockIdx.x; bu < 512; bu += gridDim.x) {
        const int tile = bu >> 4, h = bu & 15;
        const int tc0 = tile * 256, seq0 = (tc0 / S) * S, T = tc0 - seq0;
        const bf16_t* Ps = P + (size_t)seq0 * IN_A + h * 64;
        const float slope = __builtin_amdgcn_exp2f(-0.5f * (float)(h + 1)) * LOG2E;
        __syncthreads();
        stage_window(Ps + 1024, Ps + 2048, IN_A, S, T - 64, lds, tid);
        __syncthreads();
        float m[2], l[2]; f32x4 o[2][4]; int t0[2], tq[2], row0[2];
#pragma unroll
        for (int it = 0; it < 2; ++it) {
            const int res = wave + 8 * it; t0[it] = T + res; tq[it] = t0[it] + 16 * (lane & 15); row0[it] = res;
            m[it] = -1e30f; l[it] = 0.f;
#pragma unroll
            for (int n = 0; n < 4; ++n) o[it][n] = (f32x4){0.f, 0.f, 0.f, 0.f};
        }
#ifndef NO_A_G0
        { const bf16_t* const Pq[2] = {Ps, Ps}; const float sl[2] = {slope, slope};
          group_pass_lds<64, 16, 12, 2, false>(Pq, IN_A, S, tq, sl, lds, row0, t0, lane, m, l, o); }
#endif
        __syncthreads();
        asm volatile("" : "+v"(lane));
#pragma unroll
        for (int it = 0; it < 2; ++it) tq[it] = t0[it] + 16 * (lane & 15);
#ifndef NO_A_GL
        group_pass<4, 64, 4, 6, 2>(Ps + 3072, Ps + 4096, Ps + 5120, IN_A, S, t0, tq, slope * 4.f, vl, lane, m, l, o);
        group_pass<16, 64, 1, 5, 2>(Ps + 6144, Ps + 7168, Ps + 8192, IN_A, S, t0, tq, slope * 16.f, vl, lane, m, l, o);
#endif
#pragma unroll
        for (int it = 0; it < 2; ++it) attn_store(Ps + 9216, IN_A, tq[it], A + (size_t)seq0 * 1024 + h * 64, lane, l[it], o[it]);
    }
}
__device__ __forceinline__ void attn_b_phase(const bf16_t* P, bf16_t* A, int S, const float* sink, LAS unsigned char* lds, int wave, int lane_in, int tid_in) {
    int lane = lane_in, tid = tid_in; asm volatile("" : "+v"(lane), "+v"(tid));
    for (int bu = blockIdx.x; bu < 1024; bu += gridDim.x) {
        const int tile = bu >> 2, kvh = bu & 3;
        const int tc0 = tile * 128, seq0 = (tc0 / S) * S, T = tc0 - seq0;
        const bf16_t* Ps = P + (size_t)seq0 * IN_B;
        __syncthreads();
        stage_window(Ps + 1024 + kvh * 64, Ps + 1280 + kvh * 64, IN_B, S, T - 128, lds, tid);
        __syncthreads();
#pragma unroll 1
        for (int it = 0; it < 2; ++it) {
            const int h0 = kvh * 4 + 2 * it, sub = wave, tqv = T + 16 * sub + (lane & 15);
            float m[2], l[2], sl[2]; f32x4 o[2][4]; const int tq[2] = {tqv, tqv}; const int row0[2] = {16 * sub, 16 * sub};
            const bf16_t* const Pq[2] = {Ps + h0 * 64, Ps + (h0 + 1) * 64};
#pragma unroll
            for (int x = 0; x < 2; ++x) { sl[x] = __builtin_amdgcn_exp2f(-0.5f * (float)(h0 + x + 1)) * LOG2E; m[x] = sink[h0 + x] * LOG2E; l[x] = (lane < 16) ? 1.f : 0.f;
#pragma unroll
                for (int n = 0; n < 4; ++n) o[x][n] = (f32x4){0.f, 0.f, 0.f, 0.f}; }
            { const int tb[2] = {T + 16 * sub, T + 16 * sub}; group_pass_lds<128, 1, 9, 2, true>(Pq, IN_B, S, tq, sl, lds, row0, tb, lane, m, l, o); }
#pragma unroll
            for (int x = 0; x < 2; ++x) attn_store(Ps + 1536 + (h0 + x) * 64, IN_B, tqv, A + (size_t)seq0 * 1024 + (h0 + x) * 64, lane, l[x], o[x]);
        }
    }
}

__device__ __forceinline__ unsigned f2bf(float f) { unsigned u = __builtin_bit_cast(unsigned, f); return (u + 0x7fffu + ((u >> 16) & 1u)) >> 16; }
__device__ __forceinline__ unsigned pk2(float lo, float hi) { return f2bf(lo) | (f2bf(hi) << 16); }
__device__ __forceinline__ void transpose_item(const float* __restrict__ W, int K, int N, bf16_t* __restrict__ WT, LAS float* scr, int item, int lane) {
    const int nblk = N / 32, kb = item / nblk, nb = item % nblk, k0 = 64 * kb, n0 = 32 * nb;
#pragma unroll 8
    for (int i = 0; i < 32; ++i) { const int kk = 2 * i + (lane >> 5); scr[kk * 33 + (lane & 31)] = W[(size_t)(k0 + kk) * N + n0 + (lane & 31)]; }
    asm volatile("s_waitcnt lgkmcnt(0)" ::: "memory");
    const int c = lane & 7;
#pragma unroll
    for (int j = 0; j < 4; ++j) { const int n = (lane >> 3) + 8 * j; const LAS float* s = scr + (8 * c) * 33 + n;
        u32x4 o; o.x = pk2(s[0 * 33], s[1 * 33]); o.y = pk2(s[2 * 33], s[3 * 33]); o.z = pk2(s[4 * 33], s[5 * 33]); o.w = pk2(s[6 * 33], s[7 * 33]);
        *(u32x4*)(WT + (size_t)(n0 + n) * K + k0 + 8 * c) = o; }
    asm volatile("s_waitcnt lgkmcnt(0)" ::: "memory");
}

struct Args {
    const float *x_prompt, *x_sample, *c_prompt, *c_sample, *w_mod, *b_mod, *ln_g, *ln_b, *w_in_a, *w_out_a, *w_in_b, *w_out_b, *sink_b;
    float* out; unsigned char* ws; int ph_lo, ph_hi;
};

__global__ void __launch_bounds__(NWAVES * 64, 2) mk_fwd(Args a) {
    extern __shared__ __attribute__((aligned(16))) unsigned char lds_raw[];
    LAS unsigned char* lds = (LAS unsigned char*)lds_raw;
    cg::grid_group grid = cg::this_grid();
    const int wave = __builtin_amdgcn_readfirstlane((int)threadIdx.x >> 6);
#define lane0 hw_lane()
#define tid0 (wave * 64 + hw_lane())
    const int G = gridDim.x, gw = blockIdx.x * NWAVES + wave, NGW = G * NWAVES;
    unsigned char* ws = a.ws;
    float* mod = (float*)(ws + WS_MOD);
    bf16_t* WinA = (bf16_t*)(ws + WS_WINA); bf16_t* WoutA = (bf16_t*)(ws + WS_WOUTA); bf16_t* WinB = (bf16_t*)(ws + WS_WINB); bf16_t* WoutB = (bf16_t*)(ws + WS_WOUTB);
    bf16_t* U = (bf16_t*)(ws + WS_U); bf16_t* ATT = (bf16_t*)(ws + WS_ATT); bf16_t* PROJ = (bf16_t*)(ws + WS_PROJ);
    volatile LAS unsigned* bst = (volatile LAS unsigned*)(lds + 131072 + 64);
    if (threadIdx.x < 2) bst[threadIdx.x] = 0u;
    __syncthreads();
    XcdBarrier bar; bar.bar = (unsigned*)(ws + WS_BAR); bar.x = 0; bar.st = bst;
    if (a.ph_hi - a.ph_lo > 1) bar = xcd_barrier_post((unsigned*)(ws + WS_BAR), bst);
    int pc = 0;
#define RUN() (a.ph_lo <= pc && pc < a.ph_hi)
#define SEAM() do { if (a.ph_lo <= pc && pc + 1 < a.ph_hi) { if (pc == 0) grid.sync(); else xcd_barrier(bar); } ++pc; } while (0)

    if (RUN()) {
        int lane = lane0, tid = tid0; asm volatile("" : "+v"(lane), "+v"(tid));
        LAS float* scr = (LAS float*)(lds + wave * 16384);
        constexpr int I_INA = 16 * (IN_A / 32), I_OUT = 16 * 32, I_INB = 16 * (IN_B / 32);
        constexpr int NITEMS = 2 * I_INA + 2 * I_OUT + 2 * I_INB + 2 * I_OUT;
        for (int it = gw; it < NITEMS; it += NGW) {
            int r = it;
            if (r < 2 * I_INA) { const int li = r / I_INA; transpose_item(a.w_in_a + (size_t)li * DM * IN_A, DM, IN_A, WinA + (size_t)li * IN_A * DM, scr, r % I_INA, lane); continue; } r -= 2 * I_INA;
            if (r < 2 * I_OUT) { const int li = r / I_OUT; transpose_item(a.w_out_a + (size_t)li * DM * DM, DM, DM, WoutA + (size_t)li * DM * DM, scr, r % I_OUT, lane); continue; } r -= 2 * I_OUT;
            if (r < 2 * I_INB) { const int li = r / I_INB; transpose_item(a.w_in_b + (size_t)li * DM * IN_B, DM, IN_B, WinB + (size_t)li * IN_B * DM, scr, r % I_INB, lane); continue; } r -= 2 * I_INB;
            { const int li = r / I_OUT; transpose_item(a.w_out_b + (size_t)li * DM * DM, DM, DM, WoutB + (size_t)li * DM * DM, scr, r % I_OUT, lane); }
        }
        __syncthreads();
        LAS float* sc = (LAS float*)lds;
        for (int item = blockIdx.x; item < 192; item += G) {
            const int l = item / 48, r = item % 48, cgp = r >> 3, ks = r & 7;
            __syncthreads();
            for (int e = tid; e < NB * 128; e += NWAVES * 64) { const int b = e >> 7, k = ks * 128 + (e & 127);
                const float cv = b < 4 ? a.c_prompt[b * DM + k] : a.c_sample[(b - 4) * DM + k]; sc[e] = silu_f(cv); }
            __syncthreads();
            const int col = cgp * 512 + tid;
            float acc[NB];
#pragma unroll
            for (int b = 0; b < NB; ++b) acc[b] = 0.f;
            const float* wp = a.w_mod + ((size_t)l * DM + ks * 128) * 3072 + col;
#pragma unroll 4
            for (int k = 0; k < 128; ++k) { const float w = wp[(size_t)k * 3072];
#pragma unroll
                for (int b = 0; b < NB; ++b) acc[b] = fmaf(sc[b * 128 + k], w, acc[b]); }
            const float bias = (ks == 0) ? a.b_mod[l * 3072 + col] : 0.f;
#pragma unroll
            for (int b = 0; b < NB; ++b) atomicAdd(mod + ((size_t)l * NB + b) * 3072 + col, acc[b] + bias);
        }
    }
    SEAM();

    if (RUN()) {
        int lane = lane0; asm volatile("" : "+v"(lane));
        for (int row = gw; row < NTOK; row += NGW) {
            const int b = batch_of_row(row);
            const float* xr = row < NPROMPT ? a.x_prompt + (size_t)row * DM : a.x_sample + (size_t)(row - NPROMPT) * DM;
            const float* mp = mod + (size_t)b * 3072;
#pragma unroll
            for (int j = 0; j < 4; ++j) { const int c = 4 * lane + 256 * j;
                const f32x4 xv = *(const f32x4*)(xr + c), sh = *(const f32x4*)(mp + c), scl = *(const f32x4*)(mp + 1024 + c);
                const f32x4 uv = xv * (scl + 1.f) + sh;
                u32x2 w; w.x = cvtpk(uv[0], uv[1]); w.y = cvtpk(uv[2], uv[3]);
                *(u32x2*)(U + (size_t)row * DM + c) = w; }
        }
    }
    SEAM();

#pragma unroll 1
    for (int l = 0; l < DEPTH; ++l) {
        const bool isA = (l & 1) == 0; const int li = l >> 1;
        const int nch = isA ? NCH_A : NCH_B, chrows = isA ? CH_A : CH_B, ncols = isA ? IN_A : IN_B;
        const bf16_t* Win = isA ? WinA + (size_t)li * IN_A * DM : WinB + (size_t)li * IN_B * DM;
        const bf16_t* Wout = isA ? WoutA + (size_t)li * DM * DM : WoutB + (size_t)li * DM * DM;
#pragma unroll 1
        for (int c = 0; c < nch; ++c) {
            if (RUN()) {
                pg8::Gemm g{U + (size_t)c * chrows * DM, Win, chrows, ncols, DM}; pg8::StaticOrder S; S.init(chrows, ncols, G, (int)blockIdx.x);
                pg8::EpiBf16<0> E{PROJ, ncols, nullptr, 0, 0, CSCALE, isA ? 1 : 2};
#ifndef NO_GEMM_IN
                pg8::gemm_phase<pg8::EpiBf16<0>, pg8::StaticOrder, true, true>(lds, g, S, E, wave);
#endif
            }
            SEAM();
            if (RUN()) {
                const int row0 = c * chrows; const int S_ = row0 < NPROMPT ? 8192 : 4096;
#ifndef NO_ATT
#ifndef NO_ATT_A
                if (isA) attn_a_phase(PROJ, ATT + (size_t)row0 * DM, S_, lds, wave, lane0, tid0);
#endif
#ifndef NO_ATT_B
                if (!isA) attn_b_phase(PROJ, ATT + (size_t)row0 * DM, S_, a.sink_b + li * 16, lds, wave, lane0, tid0);
#endif
#endif
            }
            SEAM();
        }
        if (RUN()) {
            pg8::Gemm g{ATT, Wout, NTOK, DM, DM}; pg8::StaticOrder S; S.init(NTOK, DM, G, (int)blockIdx.x);
            pg8::EpiRes E{l == 0 ? a.x_prompt : a.out, l == 0 ? a.x_sample : a.out + (size_t)NPROMPT * DM, a.out, mod + (size_t)l * NB * 3072 + 2048, 1.681792830507429f};
#ifndef NO_GEMM_OUT
            pg8::gemm_phase<pg8::EpiRes, pg8::StaticOrder, true, true>(lds, g, S, E, wave);
#endif
        }
        SEAM();
        if (RUN()) {
            int lane = lane0; asm volatile("" : "+v"(lane));
            const float* gam = a.ln_g + l * DM; const float* bet = a.ln_b + l * DM;
            for (int row = gw; row < NTOK; row += NGW) {
                float* xr = a.out + (size_t)row * DM;
                f32x4 v[4]; float s = 0.f;
#pragma unroll
                for (int j = 0; j < 4; ++j) { v[j] = *(const f32x4*)(xr + 4 * lane + 256 * j); s += (v[j][0] + v[j][1]) + (v[j][2] + v[j][3]); }
                const float mean = wave_sum(s) * (1.f / DM); float s2 = 0.f;
#pragma unroll
                for (int j = 0; j < 4; ++j) { v[j] = v[j] - mean; s2 += (v[j][0] * v[j][0] + v[j][1] * v[j][1]) + (v[j][2] * v[j][2] + v[j][3] * v[j][3]); }
                const float rstd = 1.f / sqrtf(wave_sum(s2) * (1.f / DM) + LN_EPS);
                const int b = batch_of_row(row);
                const float* mp = mod + ((size_t)(l + 1) * NB + b) * 3072;
#pragma unroll
                for (int j = 0; j < 4; ++j) { const int cc = 4 * lane + 256 * j;
                    const f32x4 xo = v[j] * rstd * *(const f32x4*)(gam + cc) + *(const f32x4*)(bet + cc);
                    *(f32x4*)(xr + cc) = xo;
                    if (l + 1 < DEPTH) { const f32x4 sh = *(const f32x4*)(mp + cc), scl = *(const f32x4*)(mp + 1024 + cc); const f32x4 uv = xo * (scl + 1.f) + sh;
                        u32x2 w; w.x = cvtpk(uv[0], uv[1]); w.y = cvtpk(uv[2], uv[3]); *(u32x2*)(U + (size_t)row * DM + cc) = w; } }
            }
        }
        SEAM();
    }
#undef RUN
#undef SEAM
}

constexpr int N_PHASES = 2 + 2 * (2 * NCH_A + 2) + 2 * (2 * NCH_B + 2);
#ifndef ONE_LAUNCH
#define ONE_LAUNCH 1
#endif

extern "C" void kernel_launch(void* const* d_in, const int* in_sizes, int n_in, void* d_out, int out_size, void* d_ws, size_t ws_size, hipStream_t stream) {
    static int grid = 0;
    if (grid == 0) {
        if (n_in != 13 || out_size != NTOK * DM || ws_size < WS_END) { fprintf(stderr, "kernel_launch: unexpected shapes (n_in %d, out %d, ws %zu)\n", n_in, out_size, ws_size); grid = -1; return; }
        int dev = 0, cus = 0, per_cu = 0;
        (void)hipGetDevice(&dev); (void)hipDeviceGetAttribute(&cus, hipDeviceAttributeMultiprocessorCount, dev);
        if (hipFuncSetAttribute((const void*)mk_fwd, hipFuncAttributeMaxDynamicSharedMemorySize, LDS_BYTES) != hipSuccess) { fprintf(stderr, "kernel_launch: hipFuncSetAttribute failed\n"); grid = -1; return; }
        if (hipOccupancyMaxActiveBlocksPerMultiprocessor(&per_cu, (const void*)mk_fwd, NWAVES * 64, LDS_BYTES) != hipSuccess || per_cu < 1) per_cu = 1;
        (void)hipGetLastError();
        if (cus <= 0) cus = 256;
        grid = cus * per_cu;
    }
    if (grid < 0) return;
    (void)hipMemsetAsync((char*)d_ws + WS_MOD, 0, CTL_ZERO_BYTES, stream);
    Args a{};
    a.x_prompt = (const float*)d_in[0]; a.x_sample = (const float*)d_in[1]; a.c_prompt = (const float*)d_in[2]; a.c_sample = (const float*)d_in[3];
    a.w_mod = (const float*)d_in[4]; a.b_mod = (const float*)d_in[5]; a.ln_g = (const float*)d_in[6]; a.ln_b = (const float*)d_in[7];
    a.w_in_a = (const float*)d_in[8]; a.w_out_a = (const float*)d_in[9]; a.w_in_b = (const float*)d_in[10]; a.w_out_b = (const float*)d_in[11]; a.sink_b = (const float*)d_in[12];
    a.out = (float*)d_out; a.ws = (unsigned char*)d_ws;
#if ONE_LAUNCH
    a.ph_lo = 0; a.ph_hi = N_PHASES;
    void* params[] = {&a};
    hipError_t e = hipLaunchCooperativeKernel((const void*)mk_fwd, dim3(grid), dim3(NWAVES * 64), params, LDS_BYTES, stream);
    if (e != hipSuccess) fprintf(stderr, "kernel_launch: cooperative launch failed: %s (grid %d)\n", hipGetErrorString(e), grid);
#else
    for (int k = 0; k < N_PHASES; ++k) { a.ph_lo = k; a.ph_hi = k + 1; hipLaunchKernelGGL(mk_fwd, dim3(grid), dim3(NWAVES * 64), LDS_BYTES, stream, a); }
#endif
}
```

```cpp
#include <hip/hip_runtime.h>
#include <hip/hip_cooperative_groups.h>
#include <cstdio>
#include <cstdint>
namespace cg = cooperative_groups;
__device__ __forceinline__ int hw_lane() { int r; asm volatile("v_mbcnt_lo_u32_b32 %0, -1, 0\n\tv_mbcnt_hi_u32_b32 %0, -1, %0" : "=v"(r)); return r; }
namespace pg8 {
#define PG8_LAS __attribute__((address_space(3)))
typedef unsigned short bf16_t;
typedef short bf16x8 __attribute__((ext_vector_type(8)));
typedef float f32x4 __attribute__((ext_vector_type(4)));
typedef unsigned u32x4 __attribute__((ext_vector_type(4)));
constexpr int BM = 256, BK = 64, HALF = 128, HTB = HALF * BK * 2  , STAGE_BYTES = 8 * HTB, NXCD = 8, WGM = 8;

__host__ __device__ __forceinline__ int lds_byte(int r, int c) { const int st = (r >> 4) * 2 + (c >> 5), rr = r & 15, cc = c & 31, ob = rr * 64 + cc * 2; return st * 1024 + (ob ^ (((ob >> 9) & 1) << 5)); }
__host__ __device__ __forceinline__ void stage_rc(int b, int& R, int& C) { const int st = b / 1024, sb = b % 1024, swz = sb ^ (((sb >> 9) & 1) << 5); R = (st >> 1) * 16 + swz / 64; C = (st & 1) * 32 + (swz % 64) / 2; }
__host__ __device__ __forceinline__ int perm32(int rho) { const int n = rho >> 4, i = rho & 15; return 8 * (i >> 2) + 4 * n + (i & 3); }

struct Unit { int pm, pn; };
struct Gemm { const bf16_t* A; const bf16_t* Bt; int M, N, K; };

struct StaticOrder {
    int nM, nN, nwg, G, c;
    __host__ __device__ void init(int M, int N, int G_, int c_) { nM = M / BM; nN = N / BM; nwg = nM * nN; G = G_; c = c_; }
    __host__ __device__ bool next(int i, Unit& u) const {
        const long L = (long)i * G + c; if (L >= nwg) return false;
        int wgid = (int)L; { const int q = nwg / NXCD, r = nwg % NXCD, xcd = wgid % NXCD, off = wgid / NXCD; wgid = (xcd < r ? xcd * (q + 1) : r * (q + 1) + (xcd - r) * q) + off; }
        const int nig = WGM * nN, gid = wgid / nig, fm = gid * WGM, gsz = (nM - fm) < WGM ? (nM - fm) : WGM;
        u.pm = fm + ((wgid % nig) % gsz); u.pn = (wgid % nig) / gsz; return true;
    }
    __device__ __forceinline__ void a_ready(const Unit&) const {}
    __device__ __forceinline__ void done(const Unit&) const {}
};

__device__ __forceinline__ unsigned cvt_pk_bf16(float lo, float hi) { unsigned r; asm volatile("v_cvt_pk_bf16_f32 %0, %1, %2" : "=v"(r) : "v"(lo), "v"(hi)); return r; }
typedef float f32x2 __attribute__((ext_vector_type(2)));
__device__ __forceinline__ f32x2 gelu_pk(f32x2 v) {
    const f32x2 av = __builtin_elementwise_abs(v), d = av * 0.2316418882f + 1.0f;
    f32x2 t; t.x = __builtin_amdgcn_rcpf(d.x); t.y = __builtin_amdgcn_rcpf(d.y);
    f32x2 q = t * 0.5307027145f + (-0.7265760135f); q = q * t + 0.7107068705f; q = q * t + (-0.142248368f); q = q * t + 0.127414796f; q = q * t;
    const f32x2 s = (v * v) * (-0.72134752044f);
    f32x2 e; e.x = __builtin_amdgcn_exp2f(s.x); e.y = __builtin_amdgcn_exp2f(s.y);
    const f32x2 m = v * (q * e), r = v - m;
    f32x2 o; o.x = v.x < 0.f ? m.x : r.x; o.y = v.y < 0.f ? m.y : r.y; return o;
}

template <int ACT  > struct EpiBf16 {
    static constexpr bool PERM = true, AFTER_DRAIN = false; static_assert(ACT == 0 || ACT == 1, "EpiBf16: ACT is 0 (none) or 1 (gelu_pk)");
    bf16_t* O; int ldc; const float* bias; int split_cols; size_t split_stride; float scale0; int qmode;
    __device__ __forceinline__ void operator()(const f32x4 (&acc)[2][2][4][2], const Unit& u, int wr, int wc, int fr, int fq) const {
        const int row0 = u.pm * BM + wr * 64 + fr; int colt = u.pn * BM; bf16_t* base = O;
        float sc = 1.f; if (split_cols) { const int t = colt / split_cols; base += (size_t)t * split_stride; colt -= t * split_cols; if (t == 0) sc = scale0; }
        { const int blk = u.pn >> 2; if ((qmode == 1 && blk < 9 && (blk % 3) == 0) || (qmode == 2 && blk == 0)) sc = scale0; }
        const int col0 = colt + wc * 32 + 8 * fq, bcol0 = u.pn * BM + wc * 32 + 8 * fq;
        f32x4 bv[2][2];
#pragma unroll
        for (int bj = 0; bj < 2; ++bj)
#pragma unroll
            for (int n = 0; n < 2; ++n) bv[bj][n] = bias ? *(const f32x4*)(bias + bcol0 + bj * HALF + 4 * n) : (f32x4){0.f, 0.f, 0.f, 0.f};
#pragma unroll
        for (int ai = 0; ai < 2; ++ai)
#pragma unroll
            for (int m = 0; m < 4; ++m) { bf16_t* rowp = base + (size_t)(row0 + ai * HALF + m * 16) * ldc + col0;
#pragma unroll
                for (int bj = 0; bj < 2; ++bj) { f32x4 v0 = acc[ai][bj][m][0] + bv[bj][0], v1 = acc[ai][bj][m][1] + bv[bj][1];
                    if (ACT == 1) { f32x2 a = gelu_pk((f32x2){v0[0], v0[1]}), b = gelu_pk((f32x2){v0[2], v0[3]}), c = gelu_pk((f32x2){v1[0], v1[1]}), d = gelu_pk((f32x2){v1[2], v1[3]});
                        v0 = (f32x4){a.x, a.y, b.x, b.y}; v1 = (f32x4){c.x, c.y, d.x, d.y}; }
                    v0 = v0 * sc; v1 = v1 * sc; u32x4 w; w.x = cvt_pk_bf16(v0[0], v0[1]); w.y = cvt_pk_bf16(v0[2], v0[3]); w.z = cvt_pk_bf16(v1[0], v1[1]); w.w = cvt_pk_bf16(v1[2], v1[3]);
                    *(u32x4*)(rowp + bj * HALF) = w; } }
    }
};
struct PanelStats {
    unsigned* xbuf;
    unsigned* cnt;
    unsigned* tmo;
    int ntn; float eps;
    unsigned code;
    __device__ __forceinline__ bool run(const f32x4 (&v)[2][2][4][2], const Unit& u, int wr, int wc, int fr, int fq, PG8_LAS unsigned char* lds, int wid, int lane) const {
        typedef float f32x2v __attribute__((ext_vector_type(2)));
        PG8_LAS f32x2v* P = (PG8_LAS f32x2v*)lds;
        PG8_LAS f32x2v* S = (PG8_LAS f32x2v*)(lds + 8192);
        PG8_LAS unsigned* flag = (PG8_LAS unsigned*)(lds + 8192 + 2048);
#pragma unroll
        for (int ai = 0; ai < 2; ++ai)
#pragma unroll
            for (int m = 0; m < 4; ++m) {
                float s = 0.f;
#pragma unroll
                for (int bj = 0; bj < 2; ++bj)
#pragma unroll
                    for (int n = 0; n < 2; ++n) { const f32x4 x = v[ai][bj][m][n]; s += (x[0] + x[1]) + (x[2] + x[3]); }
                s += __shfl_xor(s, 16); s += __shfl_xor(s, 32);
                const float mw = s * (1.0f / 64.0f); float q = 0.f;
#pragma unroll
                for (int bj = 0; bj < 2; ++bj)
#pragma unroll
                    for (int n = 0; n < 2; ++n) { const f32x4 d = v[ai][bj][m][n] - mw; q += (d[0] * d[0] + d[1] * d[1]) + (d[2] * d[2] + d[3] * d[3]); }
                q += __shfl_xor(q, 16); q += __shfl_xor(q, 32);
                if (fq == 0) P[(ai * HALF + wr * 64 + m * 16 + fr) * 4 + wc] = (f32x2v){mw, q};
            }
        asm volatile("s_waitcnt lgkmcnt(0)" ::: "memory"); __builtin_amdgcn_s_barrier(); asm volatile("" ::: "memory");
#if defined(BROKEN_EXCHANGE_NO_WAIT)
#warning BROKEN CONTROL BUILD: the row-statistics exchange does not wait; results are wrong by design
        if (blockIdx.x >= 64) { const long long t0_ = clock64(); while (clock64() - t0_ < 60000) __builtin_amdgcn_s_sleep(8); }
#endif
        const int row = wid * 32 + (lane & 31);
        if (lane < 32) {
            const f32x2v a = P[row * 4 + 0], b = P[row * 4 + 1], c = P[row * 4 + 2], d = P[row * 4 + 3];
            const float mt = (a.x + b.x + c.x + d.x) * 0.25f;
            const float da = a.x - mt, db = b.x - mt, dc = c.x - mt, dd = d.x - mt;
            const float m2 = (a.y + b.y) + (c.y + d.y) + 64.0f * ((da * da + db * db) + (dc * dc + dd * dd));
            unsigned long long* slot = (unsigned long long*)xbuf + ((size_t)(u.pm * BM + row) * 4 + u.pn);
            __hip_atomic_store(slot, ((unsigned long long)__float_as_uint(m2) << 32) | __float_as_uint(mt), __ATOMIC_RELAXED, __HIP_MEMORY_SCOPE_AGENT);
        }
        asm volatile("s_waitcnt vmcnt(0)" ::: "memory");
        if (lane == 0) __hip_atomic_fetch_add(cnt + 16 * u.pm, 1u, __ATOMIC_RELAXED, __HIP_MEMORY_SCOPE_AGENT);
        if (wid == 0) {
            bool dead = false; const unsigned long long t0 = __builtin_amdgcn_s_memrealtime(); const unsigned want = 8u * (unsigned)ntn;
            for (;;) {
#if defined(BROKEN_EXCHANGE_NO_WAIT)
                break;
#endif
                if ((unsigned)__builtin_amdgcn_readfirstlane(__hip_atomic_load(cnt + 16 * u.pm, __ATOMIC_RELAXED, __HIP_MEMORY_SCOPE_AGENT)) >= want) break;
                if (__builtin_amdgcn_s_memrealtime() - t0 > 2000000ull) {
                    if (lane == 0) { unsigned expect = 0u; __hip_atomic_compare_exchange_strong(tmo + 1, &expect, code | (unsigned)(u.pm & 0xff), __ATOMIC_RELAXED, __ATOMIC_RELAXED, __HIP_MEMORY_SCOPE_AGENT);
                                     __hip_atomic_store(tmo, 1u, __ATOMIC_RELAXED, __HIP_MEMORY_SCOPE_AGENT); }
                    dead = true; break; }
                __builtin_amdgcn_s_sleep(2);
            }
            __builtin_amdgcn_fence(__ATOMIC_ACQUIRE, "agent");
            if (lane == 0) flag[0] = dead ? 1u : 0u;
        }
        asm volatile("s_waitcnt vmcnt(0) lgkmcnt(0)" ::: "memory"); __builtin_amdgcn_s_barrier(); asm volatile("" ::: "memory");
        const bool bad = flag[0] != 0u;
        if (lane < 32) {
            const unsigned long long* slot = (const unsigned long long*)xbuf + (size_t)(u.pm * BM + row) * 4; float mt[4], m2[4]; float ms = 0.f;
#pragma unroll
            for (int t = 0; t < 4; ++t) { if (t < ntn) { const unsigned long long w = __hip_atomic_load(slot + t, __ATOMIC_RELAXED, __HIP_MEMORY_SCOPE_AGENT); mt[t] = __uint_as_float((unsigned)w); m2[t] = __uint_as_float((unsigned)(w >> 32)); } else { mt[t] = 0.f; m2[t] = 0.f; } ms += mt[t]; }
            const float mean = ms / (float)ntn; float q = 0.f;
#pragma unroll
            for (int t = 0; t < 4; ++t) if (t < ntn) { const float dm = mt[t] - mean; q += m2[t] + 256.0f * dm * dm; }
            S[row] = (f32x2v){mean, 1.0f / sqrtf(q / (256.0f * (float)ntn) + eps)};
        }
        asm volatile("s_waitcnt lgkmcnt(0)" ::: "memory"); __builtin_amdgcn_s_barrier(); asm volatile("" ::: "memory");
        return bad;
    }
};

struct EpiLnMod {
    static constexpr bool PERM = false, AFTER_DRAIN = false;
    const float* xa; const float* xb; float* out; bf16_t* U; const float* gate_base; const float* mod_next; const float* gam; const float* bet; float alpha; PanelStats st; PG8_LAS unsigned char* xl;
    __device__ __forceinline__ void operator()(f32x4 (&acc)[2][2][4][2], const Unit& u, int wr, int wc, int fr, int fq) const {
        typedef float f32x2v __attribute__((ext_vector_type(2))); typedef unsigned u32x2v __attribute__((ext_vector_type(2)));
        const int rowt = u.pm * BM;
        const int b = rowt < 32768 ? (rowt >> 13) : 4 + ((rowt - 32768) >> 12);
        const char* xs = (const char*)(rowt < 32768 ? xa + (size_t)rowt * 1024 : xb + (size_t)(rowt - 32768) * 1024) + (size_t)(wr * 64) * 4096 + (size_t)(u.pn * BM + wc * 32) * 4;
        char* os = (char*)(out + (size_t)rowt * 1024) + (size_t)(wr * 64) * 4096 + (size_t)(u.pn * BM + wc * 32) * 4;
        char* us = (char*)(U + (size_t)rowt * 1024) + (size_t)(wr * 64) * 2048 + (size_t)(u.pn * BM + wc * 32) * 2;
        const unsigned voff = (unsigned)(fr * 1024 + 4 * fq) * 4u, voffh = voff >> 1;
        const int colb = u.pn * BM + wc * 32;
        const unsigned coff = (unsigned)(4 * fq) * 4u;
        const char* gp = (const char*)(gate_base + b * 3072 + colb);
#pragma unroll
        for (int bj = 0; bj < 2; ++bj) { f32x4 gv[2];
#pragma unroll
            for (int n = 0; n < 2; ++n) gv[n] = *(const f32x4*)(gp + (bj * HALF + n * 16) * 4 + coff);
#pragma unroll
            for (int ai = 0; ai < 2; ++ai) { f32x4 xv[4][2];
#pragma unroll
                for (int m = 0; m < 4; ++m)
#pragma unroll
                    for (int n = 0; n < 2; ++n) xv[m][n] = *(const f32x4*)(xs + (size_t)(ai * HALF + m * 16) * 4096 + (bj * HALF + n * 16) * 4 + voff);
#pragma unroll
                for (int m = 0; m < 4; ++m)
#pragma unroll
                    for (int n = 0; n < 2; ++n) acc[ai][bj][m][n] = xv[m][n] * alpha + gv[n] * acc[ai][bj][m][n];
                asm volatile("" : "+v"(acc[ai][bj][0][0]), "+v"(acc[ai][bj][1][0]), "+v"(acc[ai][bj][2][0]), "+v"(acc[ai][bj][3][0]), "+v"(acc[ai][bj][0][1]), "+v"(acc[ai][bj][1][1]), "+v"(acc[ai][bj][2][1]), "+v"(acc[ai][bj][3][1]) :: "memory"); } }
        const int wid = wr * 4 + wc, lane = fq * 16 + fr;
        const bool bad = st.run(acc, u, wr, wc, fr, fq, xl, wid, lane);
        const PG8_LAS f32x2v* S = (const PG8_LAS f32x2v*)(xl + 8192) + wr * 64 + fr;
        const float qnan = __builtin_nanf("");
        const char* gmp = (const char*)(gam + colb); const char* btp = (const char*)(bet + colb);
        const char* mp = mod_next ? (const char*)(mod_next + b * 3072 + colb) : nullptr;
#pragma unroll
        for (int bj = 0; bj < 2; ++bj) { f32x4 gm[2], bt[2], sh[2], sc1[2];
#pragma unroll
            for (int n = 0; n < 2; ++n) { const int cb = (bj * HALF + n * 16) * 4;
                gm[n] = *(const f32x4*)(gmp + cb + coff); bt[n] = *(const f32x4*)(btp + cb + coff);
                sh[n] = (f32x4){0.f, 0.f, 0.f, 0.f}; sc1[n] = (f32x4){1.f, 1.f, 1.f, 1.f};
                if (mp) { sh[n] = *(const f32x4*)(mp + cb + coff); sc1[n] = *(const f32x4*)(mp + 4096 + cb + coff) + 1.f; } }
#pragma unroll
            for (int ai = 0; ai < 2; ++ai) {
#pragma unroll
                for (int m = 0; m < 4; ++m) { const f32x2v sr = S[ai * HALF + m * 16];
#pragma unroll
                    for (int n = 0; n < 2; ++n) { const int cb = (bj * HALF + n * 16) * 4;
                        f32x4 o = (acc[ai][bj][m][n] - sr.x) * sr.y * gm[n] + bt[n];
                        if (bad) o = (f32x4){qnan, qnan, qnan, qnan};
                        *(f32x4*)(os + (size_t)(ai * HALF + m * 16) * 4096 + cb + voff) = o;
                        if (mp) { const f32x4 uv = o * sc1[n] + sh[n]; u32x2v w; w.x = cvt_pk_bf16(uv[0], uv[1]); w.y = cvt_pk_bf16(uv[2], uv[3]); *(u32x2v*)(us + (size_t)(ai * HALF + m * 16) * 2048 + (cb >> 1) + voffh) = w; } } }
                asm volatile("" ::: "memory"); } }
    }
};

struct EpiRes {
    static constexpr bool PERM = false, AFTER_DRAIN = false;
    const float* xa; const float* xb; float* out; const float* gate_base; float alpha;
    __device__ __forceinline__ void operator()(const f32x4 (&acc)[2][2][4][2], const Unit& u, int wr, int wc, int fr, int fq) const {
        const int rowt = u.pm * BM;
        const int b = rowt < 32768 ? (rowt >> 13) : 4 + ((rowt - 32768) >> 12);
        const float* xs = rowt < 32768 ? xa + (size_t)rowt * 1024 : xb + (size_t)(rowt - 32768) * 1024;
        float* os = out + (size_t)rowt * 1024;
        const float* gp = gate_base + b * 3072;
        const int col0 = u.pn * BM + wc * 32 + 4 * fq;
        f32x4 gv[2][2];
#pragma unroll
        for (int bj = 0; bj < 2; ++bj)
#pragma unroll
            for (int n = 0; n < 2; ++n) gv[bj][n] = *(const f32x4*)(gp + col0 + bj * HALF + n * 16);
#pragma unroll
        for (int ai = 0; ai < 2; ++ai)
#pragma unroll
            for (int m = 0; m < 4; ++m) { const size_t off = (size_t)(wr * 64 + fr + ai * HALF + m * 16) * 1024 + col0;
#pragma unroll
                for (int bj = 0; bj < 2; ++bj)
#pragma unroll
                    for (int n = 0; n < 2; ++n) { const f32x4 xv = *(const f32x4*)(xs + off + bj * HALF + n * 16);
                        *(f32x4*)(os + off + bj * HALF + n * 16) = xv * alpha + gv[bj][n] * acc[ai][bj][m][n]; } }
    }
};
template <class Epi, class Sched, bool ALIGN_EPI = false, bool SP2 = false>
__device__ __forceinline__ void gemm_phase(PG8_LAS unsigned char* lds, const Gemm g, const Sched& S, const Epi& E, int wave_in) {
    int tid_l = wave_in * 64 + hw_lane(); asm volatile("" : "+v"(tid_l));
    const int tid = tid_l, wid = __builtin_amdgcn_readfirstlane(tid >> 6), lane = tid & 63, wr = wid >> 2, wc = wid & 3, fr = lane & 15, fq = lane >> 4;
    const int K = g.K, nt = K / BK;
    unsigned voffA[2], voffB[2];
#pragma unroll
    for (int i = 0; i < 2; ++i) { int R, C; stage_rc(tid * 16 + i * 8192, R, C); const int Rb = Epi::PERM ? ((R & ~31) + perm32(R & 31)) : R;
        voffA[i] = (unsigned)(R * K + C) * 2u; voffB[i] = (unsigned)(Rb * K + C) * 2u; }
    const size_t kstep = (size_t)(BK * 2);
    const size_t hstep = (size_t)HALF * K * 2;
    const size_t tstep = 2 * hstep;
    const unsigned ldsw = (unsigned)wid * 1024u;
    const int aoff = lds_byte(wr * 64 + fr, fq * 8), boff = lds_byte(wc * 32 + fr, fq * 8);
#define PG8_SA(b, h) (((b) * 2 + (h)) * HTB)
#define PG8_SB(b, h) ((4 + (b) * 2 + (h)) * HTB)
#define PG8_STAGE(bufoff, gbase, voff) do { _Pragma("unroll") for (int _i = 0; _i < 2; ++_i) \
        __builtin_amdgcn_global_load_lds((const unsigned*)((const char*)(gbase) + (voff)[_i]), (PG8_LAS unsigned*)(lds + (bufoff) + ldsw + _i * 8192), 16, 0, 0); } while (0)
#define PG8_LDA(dst, b, h) do { _Pragma("unroll") for (int m = 0; m < 4; ++m) _Pragma("unroll") for (int k = 0; k < 2; ++k) dst[m][k] = *(const PG8_LAS bf16x8*)(lds + PG8_SA(b, h) + aoff + m * 2048 + k * 1024); } while (0)
#define PG8_LDB(dst, b, h) do { _Pragma("unroll") for (int n = 0; n < 2; ++n) _Pragma("unroll") for (int k = 0; k < 2; ++k) dst[n][k] = *(const PG8_LAS bf16x8*)(lds + PG8_SB(b, h) + boff + n * 2048 + k * 1024); } while (0)
#define PG8_MMA(ai, bj, At, Bt) do { __builtin_amdgcn_s_setprio(1); _Pragma("unroll") for (int m = 0; m < 4; ++m) _Pragma("unroll") for (int n = 0; n < 2; ++n) _Pragma("unroll") for (int k = 0; k < 2; ++k) \
        acc[ai][bj][m][n] = __builtin_amdgcn_mfma_f32_16x16x32_bf16(Bt[n][k], At[m][k], acc[ai][bj][m][n], 0, 0, 0); __builtin_amdgcn_s_setprio(0); } while (0)
#define PG8_WAIT_V(n) asm volatile("s_waitcnt vmcnt(" #n ")" ::: "memory")
#define PG8_WAIT_L(n) asm volatile("s_waitcnt lgkmcnt(" #n ")" ::: "memory")
#define PG8_BAR __builtin_amdgcn_s_barrier()
#define PG8_SCHED __builtin_amdgcn_sched_barrier(0)
    Unit cur, nxt; int ui = 0;
    if (!S.next(0, cur)) return;
    f32x4 acc[2][2][4][2];
#pragma unroll
    for (int a = 0; a < 2; ++a)
#pragma unroll
        for (int b = 0; b < 2; ++b)
#pragma unroll
            for (int m = 0; m < 4; ++m)
#pragma unroll
                for (int n = 0; n < 2; ++n) acc[a][b][m][n] = (f32x4){0.f, 0.f, 0.f, 0.f};
    bf16x8 At[4][2], B0[2][2], B1[2][2];
    const char* cA = (const char*)g.A + (size_t)cur.pm * tstep; const char* cB = (const char*)g.Bt + (size_t)cur.pn * tstep;
    S.a_ready(cur);
    if constexpr (SP2) {
        PG8_STAGE(PG8_SB(0, 0), cB, voffB); PG8_STAGE(PG8_SB(0, 1), cB + hstep, voffB); PG8_STAGE(PG8_SA(0, 0), cA, voffA); PG8_STAGE(PG8_SA(0, 1), cA + hstep, voffA);
        if (wr == 1) PG8_BAR;
        PG8_WAIT_V(2); PG8_BAR;
        PG8_STAGE(PG8_SB(1, 0), cB + kstep, voffB); PG8_STAGE(PG8_SA(1, 0), cA + kstep, voffA); PG8_STAGE(PG8_SB(1, 1), cB + hstep + kstep, voffB);
        PG8_WAIT_V(6); PG8_BAR;
    } else {
        PG8_STAGE(PG8_SB(0, 0), cB, voffB); PG8_STAGE(PG8_SA(0, 0), cA, voffA); PG8_STAGE(PG8_SB(0, 1), cB + hstep, voffB); PG8_STAGE(PG8_SA(0, 1), cA + hstep, voffA);
        if (wr == 1) PG8_BAR;
        PG8_WAIT_V(4); PG8_BAR;
        PG8_STAGE(PG8_SB(1, 0), cB + kstep, voffB); PG8_STAGE(PG8_SA(1, 0), cA + kstep, voffA); PG8_STAGE(PG8_SB(1, 1), cB + hstep + kstep, voffB);
        PG8_WAIT_V(6); PG8_BAR;
    }
    for (;;) {
        const bool has_next = S.next(ui + 1, nxt);
        const char* nA = has_next ? (const char*)g.A + (size_t)nxt.pm * tstep : cA; const char* nB = has_next ? (const char*)g.Bt + (size_t)nxt.pn * tstep : cB;
        for (int t = 0; t < nt; t += 2) {
            const bool last = (t == nt - 2);
            const char* a1 = cA + (size_t)(t + 1) * kstep;
            const char* a2 = last ? nA : cA + (size_t)(t + 2) * kstep; const char* b2 = last ? nB : cB + (size_t)(t + 2) * kstep;
            const char* a3 = a2 + kstep; const char* b3 = b2 + kstep;
            if (last && has_next) S.a_ready(nxt);
            if constexpr (SP2) {
            PG8_LDB(B0, 0, 0); PG8_LDB(B1, 0, 1); PG8_SCHED; PG8_LDA(At, 0, 0); PG8_STAGE(PG8_SA(1, 1), a1 + hstep, voffA);
            PG8_WAIT_V(8); PG8_WAIT_L(0); PG8_BAR; PG8_MMA(0, 0, At, B0); PG8_MMA(0, 1, At, B1); PG8_BAR; PG8_SCHED;
            PG8_LDA(At, 0, 1); PG8_STAGE(PG8_SB(0, 0), b2, voffB); PG8_STAGE(PG8_SB(0, 1), b2 + hstep, voffB); PG8_STAGE(PG8_SA(0, 0), a2, voffA);
            PG8_WAIT_V(8); PG8_WAIT_L(0); PG8_BAR; PG8_MMA(1, 0, At, B0); PG8_MMA(1, 1, At, B1); PG8_BAR; PG8_SCHED;
            PG8_LDB(B0, 1, 0); PG8_LDB(B1, 1, 1); PG8_SCHED; PG8_LDA(At, 1, 0); PG8_STAGE(PG8_SA(0, 1), a2 + hstep, voffA);
            PG8_WAIT_V(8); PG8_WAIT_L(0); PG8_BAR; PG8_MMA(0, 0, At, B0); PG8_MMA(0, 1, At, B1); PG8_BAR; PG8_SCHED;
            PG8_LDA(At, 1, 1); PG8_STAGE(PG8_SB(1, 0), b3, voffB); PG8_STAGE(PG8_SB(1, 1), b3 + hstep, voffB); PG8_STAGE(PG8_SA(1, 0), a3, voffA);
            PG8_WAIT_V(8); PG8_WAIT_L(0); PG8_BAR; PG8_MMA(1, 0, At, B0); PG8_MMA(1, 1, At, B1); PG8_BAR; PG8_SCHED;
            } else {
            PG8_LDB(B0, 0, 0); PG8_SCHED; PG8_LDA(At, 0, 0); PG8_STAGE(PG8_SA(1, 1), a1 + hstep, voffA);
            PG8_WAIT_L(8); PG8_BAR; PG8_WAIT_L(0); PG8_MMA(0, 0, At, B0); PG8_BAR; PG8_SCHED;
            PG8_LDB(B1, 0, 1); PG8_STAGE(PG8_SB(0, 0), b2, voffB);
            PG8_BAR; PG8_WAIT_L(0); PG8_MMA(0, 1, At, B1); PG8_BAR;
            PG8_LDA(At, 0, 1); PG8_STAGE(PG8_SA(0, 0), a2, voffA);
            PG8_BAR; PG8_WAIT_L(0); PG8_MMA(1, 0, At, B0); PG8_BAR; PG8_SCHED;
            PG8_STAGE(PG8_SB(0, 1), b2 + hstep, voffB);
            PG8_WAIT_V(6); PG8_BAR; PG8_MMA(1, 1, At, B1); PG8_BAR;
            PG8_LDB(B0, 1, 0); PG8_SCHED; PG8_LDA(At, 1, 0); PG8_STAGE(PG8_SA(0, 1), a2 + hstep, voffA);
            PG8_WAIT_L(8); PG8_BAR; PG8_WAIT_L(0); PG8_MMA(0, 0, At, B0); PG8_BAR; PG8_SCHED;
            PG8_LDB(B1, 1, 1); PG8_STAGE(PG8_SB(1, 0), b3, voffB);
            PG8_BAR; PG8_WAIT_L(0); PG8_MMA(0, 1, At, B1); PG8_BAR;
            PG8_LDA(At, 1, 1); PG8_STAGE(PG8_SA(1, 0), a3, voffA);
            PG8_BAR; PG8_WAIT_L(0); PG8_MMA(1, 0, At, B0); PG8_BAR; PG8_SCHED;
            PG8_STAGE(PG8_SB(1, 1), b3 + hstep, voffB);
            PG8_WAIT_V(6); PG8_BAR; PG8_MMA(1, 1, At, B1); PG8_BAR;
            }
        }
        if constexpr (ALIGN_EPI) { if (wr == 0) PG8_BAR; }
        if constexpr (!Epi::AFTER_DRAIN) { E(acc, cur, wr, wc, fr, fq); S.done(cur); }
        if (!has_next) break;
#pragma unroll
        for (int a = 0; a < 2; ++a)
#pragma unroll
            for (int b = 0; b < 2; ++b)
#pragma unroll
                for (int m = 0; m < 4; ++m)
#pragma unroll
                    for (int n = 0; n < 2; ++n) acc[a][b][m][n] = (f32x4){0.f, 0.f, 0.f, 0.f};
        cur = nxt; cA = nA; cB = nB; ++ui;
        if constexpr (ALIGN_EPI) { if (wr == 1) PG8_BAR; }
    }
    PG8_WAIT_V(0);
    if constexpr (!ALIGN_EPI) { if (wr == 0) PG8_BAR; }
    PG8_BAR;
    if constexpr (Epi::AFTER_DRAIN) { E.fused(acc, cur, wr, wc, fr, fq, lds, wid, lane); S.done(cur); }
#undef PG8_SA
#undef PG8_SB
#undef PG8_STAGE
#undef PG8_LDA
#undef PG8_LDB
#undef PG8_MMA
#undef PG8_WAIT_V
#undef PG8_WAIT_L
#undef PG8_BAR
#undef PG8_SCHED
}
}
constexpr int DM = 1024, NTOK = 65536, NPROMPT = 32768, NB = 12, DEPTH = 4;
constexpr int IN_A = 10240, IN_B = 2560;
constexpr int CH_A = 8192, NCH_A = 8, CH_B = 32768, NCH_B = 2;
constexpr float LN_EPS = 1e-5f;
constexpr float LOG2E = 1.4426950408889634f;
constexpr float CSCALE = 0.125f * LOG2E;
constexpr size_t MiB = 1u << 20;
constexpr size_t WS_MOD = 0, CTL_ZERO_BYTES = 1 * MiB;
constexpr size_t WS_BAR = 640 * 1024;
constexpr size_t WS_WINA = 2 * MiB;
constexpr size_t WS_WOUTA = 42 * MiB;
constexpr size_t WS_WINB = 46 * MiB;
constexpr size_t WS_WOUTB = 56 * MiB;
constexpr size_t WS_U = 64 * MiB;
constexpr size_t WS_ATT = 192 * MiB;
constexpr size_t WS_PROJ = 320 * MiB;
constexpr size_t WS_XBUF = 480 * MiB;
constexpr size_t WS_END = 482 * MiB;
constexpr size_t WS_TMO = 700 * 1024, WS_CNT = 704 * 1024;
constexpr int LDS_BYTES = 147456;
constexpr int NWAVES = 8;

#define LAS __attribute__((address_space(3)))
typedef unsigned short bf16_t;
typedef short bf16x8 __attribute__((ext_vector_type(8)));
typedef short s16x4 __attribute__((ext_vector_type(4)));
typedef float f32x4 __attribute__((ext_vector_type(4)));
typedef float f32x2 __attribute__((ext_vector_type(2)));
typedef unsigned u32x4 __attribute__((ext_vector_type(4)));
typedef unsigned u32x2 __attribute__((ext_vector_type(2)));
typedef __bf16 bf16x2_t __attribute__((ext_vector_type(2)));
typedef short v4i16_t __attribute__((ext_vector_type(4)));

__device__ __forceinline__ unsigned cvtpk(float lo, float hi) { f32x2 v = {lo, hi}; bf16x2_t b = __builtin_convertvector(v, bf16x2_t); return __builtin_bit_cast(unsigned, b); }
__device__ __forceinline__ float bf_lo(unsigned w) { return __uint_as_float(w << 16); }
__device__ __forceinline__ float bf_hi(unsigned w) { return __uint_as_float(w & 0xffff0000u); }
__device__ __forceinline__ float silu_f(float z) { return z / (1.f + __expf(-z)); }
__device__ __forceinline__ int batch_of_row(int row) { return row < NPROMPT ? (row >> 13) : 4 + ((row - NPROMPT) >> 12); }
__device__ __forceinline__ float wave_sum(float v, int lane) {
#pragma unroll
    for (int o = 1; o < 64; o <<= 1) v += __builtin_bit_cast(float, __builtin_amdgcn_ds_bpermute((lane ^ o) << 2, __builtin_bit_cast(int, v)));
    return v;
}

#define XB_TMO      128
#define XB_XCNT(j)  (256  + 64 * (j))
#define XB_XSUB(j)  (1280 + 64 * (j))
#define XB_XGEN(j)  (2304 + 64 * (j))
#define XB_TOP      3328
#define XB_TOPGEN   3392
#define XCD_BAR_WORDS 3456
#define XB_SPIN_CAP (1u << 18)

__device__ __forceinline__ unsigned xb_ld(unsigned* p)              { return __hip_atomic_load(p, __ATOMIC_RELAXED, __HIP_MEMORY_SCOPE_AGENT); }
__device__ __forceinline__ unsigned xb_add(unsigned* p, unsigned v) { return __hip_atomic_fetch_add(p, v, __ATOMIC_RELAXED, __HIP_MEMORY_SCOPE_AGENT); }
__device__ __forceinline__ unsigned xb_xcc_id() { return (unsigned)__builtin_amdgcn_s_getreg((3 << 11) | 20) & 0xFu; }
#define XB_SPIN(cond, bar) do { unsigned _sp = 0; while (cond) { __builtin_amdgcn_s_sleep(1); \
    if ((++_sp & 255u) == 0u) { if (xb_ld(&(bar)[XB_TMO])) break; if (_sp > XB_SPIN_CAP) { atomicAdd(&(bar)[XB_TMO], 1u); break; } } } } while (0)

struct XcdBarrier {
    unsigned* bar; unsigned x;
    volatile LAS unsigned* st;
};

__device__ __forceinline__ XcdBarrier xcd_barrier_post(unsigned* bar, volatile LAS unsigned* st) {
    XcdBarrier b; b.bar = bar; b.x = xb_xcc_id(); b.st = st;
    if (threadIdx.x == 0) (void)xb_add(&bar[XB_XCNT(b.x)], 1u);
    return b;
}
__device__ __forceinline__ void xcd_barrier_complete(unsigned* bar, unsigned x, unsigned& nloc, unsigned& nx) {
    const unsigned G = gridDim.x * gridDim.y * gridDim.z;
    unsigned sum, cnt, mine, sp = 0u;
    for (;;) {
        sum = 0u; cnt = 0u; mine = 0u;
#pragma unroll
        for (unsigned j = 0; j < 16; ++j) { const unsigned c = xb_ld(&bar[XB_XCNT(j)]); sum += c; cnt += (c > 0u) ? 1u : 0u; }
        mine = xb_ld(&bar[XB_XCNT(x)]);
        if (sum == G) break;
        __builtin_amdgcn_s_sleep(1);
        if ((++sp & 255u) == 0u) { if (xb_ld(&bar[XB_TMO])) break; if (sp > XB_SPIN_CAP) { atomicAdd(&bar[XB_TMO], 1u); break; } }
    }
    nloc = mine > 0u ? mine : 1u; nx = cnt > 0u ? cnt : 1u;
}

__device__ __forceinline__ void xcd_barrier(const XcdBarrier& b) {
    asm volatile("s_waitcnt vmcnt(0)" ::: "memory");
    __syncthreads();
    if (threadIdx.x == 0) {
        unsigned* bar = b.bar;
        __builtin_amdgcn_s_waitcnt(0);
        unsigned nloc = b.st[0], nx = b.st[1];
        if (nloc == 0u) { xcd_barrier_complete(bar, b.x, nloc, nx); b.st[0] = nloc; b.st[1] = nx; }
        const unsigned old = xb_add(&bar[XB_XSUB(b.x)], 1u);
        const unsigned gen = old / nloc;
        if (old + 1u == (gen + 1u) * nloc) {
            __builtin_amdgcn_fence(__ATOMIC_RELEASE, "agent");
            asm volatile("s_waitcnt vmcnt(0)" ::: "memory");
            const unsigned og = xb_add(&bar[XB_TOP], 1u);
            const unsigned tg = og / nx;
            if (og + 1u == (tg + 1u) * nx) xb_add(&bar[XB_TOPGEN], 1u);
            else XB_SPIN(xb_ld(&bar[XB_TOPGEN]) == tg, bar);
            __builtin_amdgcn_fence(__ATOMIC_ACQUIRE, "agent");
            xb_add(&bar[XB_XGEN(b.x)], 1u);
            asm volatile("s_waitcnt vmcnt(0)" ::: "memory");
        } else {
            XB_SPIN(xb_ld(&bar[XB_XGEN(b.x)]) == gen, bar);
            __builtin_amdgcn_fence(__ATOMIC_ACQUIRE, "agent");
            asm volatile("s_waitcnt vmcnt(0)" ::: "memory");
        }
    }
    __syncthreads();
}

__device__ __forceinline__ float q4_max(float v) {
    auto r = __builtin_amdgcn_permlane16_swap(__float_as_uint(v), __float_as_uint(v), false, false); v = fmaxf(__uint_as_float(r[0]), __uint_as_float(r[1]));
    auto q = __builtin_amdgcn_permlane32_swap(__float_as_uint(v), __float_as_uint(v), false, false); return fmaxf(__uint_as_float(q[0]), __uint_as_float(q[1]));
}
__device__ __forceinline__ float q4_sum(float v) {
    auto r = __builtin_amdgcn_permlane16_swap(__float_as_uint(v), __float_as_uint(v), false, false); v = __uint_as_float(r[0]) + __uint_as_float(r[1]);
    auto q = __builtin_amdgcn_permlane32_swap(__float_as_uint(v), __float_as_uint(v), false, false); return __uint_as_float(q[0]) + __uint_as_float(q[1]);
}
template <int NI, bool FAST>
__device__ __forceinline__ void sm_soft_n(const f32x4 (&sa)[NI][2], float rb, const float (&lo)[NI], const float (&hi)[NI], const float (&slope2)[NI], float (&m)[NI], float (&l)[NI],
                                          f32x4 (&o)[NI][4], bf16x8 (&pb)[NI]) {
    float sc[NI][8], mx[NI];
#pragma unroll
    for (int t_ = 0; t_ < 2; ++t_)
#pragma unroll
        for (int r = 0; r < 4; ++r) {
            const float relf = rb + (float)(16 * t_ + r), arel = fabsf(relf);
#pragma unroll
            for (int x = 0; x < NI; ++x) {
                const float v = fmaf(-slope2[x], arel, sa[x][t_][r]);
                sc[x][4 * t_ + r] = (FAST || (relf >= lo[x] && relf <= hi[x])) ? v : -1e30f;
            }
        }
    bool need = false;
#pragma unroll
    for (int x = 0; x < NI; ++x) {
        mx[x] = fmaxf(fmaxf(fmaxf(sc[x][0], sc[x][1]), fmaxf(sc[x][2], sc[x][3])), fmaxf(fmaxf(sc[x][4], sc[x][5]), fmaxf(sc[x][6], sc[x][7])));
        mx[x] = q4_max(mx[x]);
        need = need || (mx[x] > m[x] + 8.f);
    }
    if (__any(need)) {
#pragma unroll
        for (int x = 0; x < NI; ++x) {
            const float mn = fmaxf(m[x], mx[x]), alpha = __builtin_amdgcn_exp2f(m[x] - mn); m[x] = mn;
            l[x] = l[x] * alpha;
#pragma unroll
            for (int n = 0; n < 4; ++n) o[x][n] = o[x][n] * alpha;
        }
    }
#pragma unroll
    for (int x = 0; x < NI; ++x) {
        float ps = 0.f;
#pragma unroll
        for (int k = 0; k < 8; ++k) { sc[x][k] = __builtin_amdgcn_exp2f(sc[x][k] - m[x]); ps += sc[x][k]; }
        l[x] += ps;
        u32x4 pw; pw.x = cvtpk(sc[x][0], sc[x][1]); pw.y = cvtpk(sc[x][2], sc[x][3]); pw.z = cvtpk(sc[x][4], sc[x][5]); pw.w = cvtpk(sc[x][6], sc[x][7]);
        pb[x] = __builtin_bit_cast(bf16x8, pw);
    }
}
__device__ __forceinline__ void load_vfrag(LAS unsigned char* vb, bf16x8 (&va)[4]) {
#pragma unroll
    for (int n = 0; n < 4; ++n) {
        const s16x4 v0 = __builtin_bit_cast(s16x4, __builtin_amdgcn_ds_read_tr16_b64_v4i16((LAS v4i16_t*)(vb + n * 32)));
        const s16x4 v1 = __builtin_bit_cast(s16x4, __builtin_amdgcn_ds_read_tr16_b64_v4i16((LAS v4i16_t*)(vb + n * 32 + 2560)));
        va[n] = (bf16x8){v0[0], v0[1], v0[2], v0[3], v1[0], v1[1], v1[2], v1[3]};
    }
}
__device__ __forceinline__ void pv_step(const bf16x8 (&va)[4], bf16x8 pb, f32x4 (&o)[4]) {
#pragma unroll
    for (int n = 0; n < 4; ++n) o[n] = __builtin_amdgcn_mfma_f32_16x16x32_bf16(va[n], pb, o[n], 0, 0, 0);
}
template <int D_, int NS, int QSTEP, int NSTEPS, int NI>
__device__ __forceinline__ void group_pass(const bf16_t* __restrict__ Pq, const bf16_t* __restrict__ Pk, const bf16_t* __restrict__ Pv, int pitch, int S, const int (&t0)[NI], const int (&tq)[NI],
                                           float slope2, LAS unsigned char* vl  , int lane, float (&m)[NI], float (&l)[NI], f32x4 (&o)[NI][4]) {
    const int i = lane & 15, g = lane >> 4;
    bf16x8 qb[NI][2]; float lo[NI], hi[NI];
#pragma unroll
    for (int x = 0; x < NI; ++x) {
#pragma unroll
        for (int s = 0; s < 2; ++s) qb[x][s] = *(const bf16x8*)((const char*)Pq + (unsigned)(tq[x] * pitch + 8 * g) * 2u + 64 * s);
        const int lo_i = -(tq[x] / D_), hi_i = (S - 1 - tq[x]) / D_;
        lo[x] = (float)(lo_i > -NS ? lo_i : -NS); hi[x] = (float)(hi_i < NS ? hi_i : NS);
    }
    const float relbase = (float)(-NS + 4 * g - QSTEP * i);
    const int vk = lane >> 3, vc = lane & 7;
    LAS unsigned char* vw = vl + vk * 160 + vc * 16;
    LAS unsigned char* vb = vl + (4 * g + ((lane & 15) >> 2)) * 160 + 8 * (lane & 3);
    bf16x8 kn[NI][2][2]; u32x4 vn[NI][4];
    int kof[NI], vof[NI];
#pragma unroll
    for (int x = 0; x < NI; ++x) { kof[x] = ((t0[x] + D_ * (i - NS)) * pitch + 8 * g) * 2; vof[x] = ((t0[x] + D_ * (vk - NS)) * pitch + 8 * vc) * 2; }
    const int sstride = 32 * D_ * pitch * 2, tstride = 16 * D_ * pitch * 2, cstride = 8 * D_ * pitch * 2;
#define ATT_INR(x, st_) (t0[x] + D_ * (32 * (st_) - NS) >= 0 && t0[x] + D_ * (32 * (st_) + 31 - NS) <= S - 1)
#define ATT_LOAD(st_) do { _Pragma("unroll") for (int x = 0; x < NI; ++x) { \
        if (ATT_INR(x, st_)) { \
            _Pragma("unroll") for (int t_ = 0; t_ < 2; ++t_) _Pragma("unroll") for (int s = 0; s < 2; ++s) kn[x][t_][s] = *(const bf16x8*)((const char*)Pk + (unsigned)(kof[x] + (st_) * sstride + t_ * tstride) + 64 * s); \
            _Pragma("unroll") for (int c = 0; c < 4; ++c) vn[x][c] = *(const u32x4*)((const char*)Pv + (unsigned)(vof[x] + (st_) * sstride + c * cstride)); \
        } else { \
        _Pragma("unroll") for (int t_ = 0; t_ < 2; ++t_) { int tk = t0[x] + D_ * (32 * (st_) + 16 * t_ + i - NS); tk = tk < 0 ? 0 : (tk > S - 1 ? S - 1 : tk); \
            const unsigned ko = (unsigned)(tk * pitch + 8 * g) * 2u; \
            _Pragma("unroll") for (int s = 0; s < 2; ++s) kn[x][t_][s] = *(const bf16x8*)((const char*)Pk + ko + 64 * s); } \
        _Pragma("unroll") for (int c = 0; c < 4; ++c) { int tk = t0[x] + D_ * (32 * (st_) + 8 * c + vk - NS); tk = tk < 0 ? 0 : (tk > S - 1 ? S - 1 : tk); \
            vn[x][c] = *(const u32x4*)((const char*)Pv + (unsigned)(tk * pitch + 8 * vc) * 2u); } } } } while (0)
    ATT_LOAD(0);
#pragma unroll 1
    for (int st = 0; st < NSTEPS; ++st) {
        f32x4 sa[NI][2]; bf16x8 va[NI][4]; bf16x8 pb[NI];
        const bool interior = (32 * st - NS - 15 * QSTEP >= -NS) && (32 * st + 31 - NS <= NS);
        bool fast[NI];
#pragma unroll
        for (int x = 0; x < NI; ++x) {
            fast[x] = interior && ATT_INR(x, st);
#pragma unroll
            for (int c = 0; c < 4; ++c) *(LAS u32x4*)(vw + x * 5120 + c * 1280) = vn[x][c];
#pragma unroll
            for (int t_ = 0; t_ < 2; ++t_) {
                sa[x][t_] = __builtin_amdgcn_mfma_f32_16x16x32_bf16(kn[x][t_][0], qb[x][0], (f32x4){0.f, 0.f, 0.f, 0.f}, 0, 0, 0);
                sa[x][t_] = __builtin_amdgcn_mfma_f32_16x16x32_bf16(kn[x][t_][1], qb[x][1], sa[x][t_], 0, 0, 0);
            }
        }
        if (st + 1 < NSTEPS) ATT_LOAD(st + 1);
        { bool fj = true; float sl2[NI];
#pragma unroll
          for (int x = 0; x < NI; ++x) { fj = fj && fast[x]; sl2[x] = slope2; }
          if (fj) sm_soft_n<NI, true>(sa, relbase + (float)(32 * st), lo, hi, sl2, m, l, o, pb); else sm_soft_n<NI, false>(sa, relbase + (float)(32 * st), lo, hi, sl2, m, l, o, pb); }
#pragma unroll
        for (int x = 0; x < NI; ++x) load_vfrag(vb + x * 5120, va[x]);
#pragma unroll
        for (int x = 0; x < NI; ++x) pv_step(va[x], pb[x], o[x]);
    }
#undef ATT_INR
#undef ATT_LOAD
}
constexpr int KROW = 144, VROW = 160, WROWS = 416;
constexpr int WIN_K = 0, WIN_V = WROWS * KROW, WIN_BYTES = WROWS * (KROW + VROW);
template <int NS, int QSTEP, int NSTEPS, int NI, bool SHARED>
__device__ __forceinline__ void group_pass_lds(const bf16_t* const (&Pq)[NI], int pitch, int S, const int (&tq)[NI], const float (&slope2)[NI], LAS unsigned char* win, const int (&row0)[NI], const int (&tb)[NI],
                                               int lane, float (&m)[NI], float (&l)[NI], f32x4 (&o)[NI][4]) {
    const int i = lane & 15, g = lane >> 4;
    bf16x8 qb[NI][2]; float lo[NI], hi[NI];
    LAS unsigned char* kb[NI]; LAS unsigned char* vb[NI];
#pragma unroll
    for (int x = 0; x < NI; ++x) {
#pragma unroll
        for (int s = 0; s < 2; ++s) qb[x][s] = *(const bf16x8*)((const char*)Pq[x] + (unsigned)(tq[x] * pitch + 8 * g) * 2u + 64 * s);
        const int lo_i = -tq[x], hi_i = S - 1 - tq[x];
        lo[x] = (float)(lo_i > -NS ? lo_i : -NS); hi[x] = (float)(hi_i < NS ? hi_i : NS);
        kb[x] = win + WIN_K + (row0[x] + i) * KROW + 16 * g;
        vb[x] = win + WIN_V + (row0[x] + 4 * g + ((lane & 15) >> 2)) * VROW + 8 * (lane & 3);
    }
    const float relbase = (float)(-NS + 4 * g - QSTEP * i);
#pragma unroll 1
    for (int st = 0; st < NSTEPS; ++st) {
        f32x4 sa[NI][2]; bf16x8 va[NI][4]; bf16x8 pb[NI];
        const bool interior = (32 * st - NS - 15 * QSTEP >= -NS) && (32 * st + 31 - NS <= NS);
        bool fast[NI];
#pragma unroll
        for (int x = 0; x < NI; ++x) fast[x] = interior && (tb[x] + 32 * st - NS >= 0) && (tb[x] + 32 * st + 31 - NS <= S - 1);
#pragma unroll
        for (int x = 0; x < NI; ++x) {
            if (!SHARED || x == 0) {
                bf16x8 kf[2][2];
#pragma unroll
                for (int t_ = 0; t_ < 2; ++t_) { kf[t_][0] = *(LAS bf16x8*)(kb[x] + (32 * st + 16 * t_) * KROW); kf[t_][1] = *(LAS bf16x8*)(kb[x] + (32 * st + 16 * t_) * KROW + 64); }
                if (SHARED) load_vfrag(vb[x] + 32 * st * VROW, va[x]);
#pragma unroll
                for (int y = 0; y < NI; ++y) if (y == x || (SHARED && x == 0)) {
#pragma unroll
                    for (int t_ = 0; t_ < 2; ++t_) {
                        sa[y][t_] = __builtin_amdgcn_mfma_f32_16x16x32_bf16(kf[t_][0], qb[y][0], (f32x4){0.f, 0.f, 0.f, 0.f}, 0, 0, 0);
                        sa[y][t_] = __builtin_amdgcn_mfma_f32_16x16x32_bf16(kf[t_][1], qb[y][1], sa[y][t_], 0, 0, 0);
                    }
                }
            }
        }
        { bool fj = true;
#pragma unroll
          for (int x = 0; x < NI; ++x) fj = fj && fast[x];
          if (fj) sm_soft_n<NI, true>(sa, relbase + (float)(32 * st), lo, hi, slope2, m, l, o, pb); else sm_soft_n<NI, false>(sa, relbase + (float)(32 * st), lo, hi, slope2, m, l, o, pb); }
        if (!SHARED) {
#pragma unroll
            for (int x = 0; x < NI; ++x) load_vfrag(vb[x] + 32 * st * VROW, va[x]);
        }
#pragma unroll
        for (int x = 0; x < NI; ++x) pv_step(va[SHARED ? 0 : x], pb[x], o[x]);
    }
}
__device__ __forceinline__ void stage_window(const bf16_t* __restrict__ Pk, const bf16_t* __restrict__ Pv, int pitch, int S, int w0, LAS unsigned char* lds, int tid) {
    u32x4 kr[7], vr[7];
#pragma unroll
    for (int j = 0; j < 7; ++j) { const int e = tid + 512 * j, row = e >> 3, ch = e & 7; int tk = w0 + row; tk = tk < 0 ? 0 : (tk > S - 1 ? S - 1 : tk);
        if (e < WROWS * 8) { const unsigned off = (unsigned)(tk * pitch + ch * 8) * 2u; kr[j] = *(const u32x4*)((const char*)Pk + off); vr[j] = *(const u32x4*)((const char*)Pv + off); } }
#pragma unroll
    for (int j = 0; j < 7; ++j) { const int e = tid + 512 * j, row = e >> 3, ch = e & 7;
        if (e < WROWS * 8) { *(LAS u32x4*)(lds + WIN_K + row * KROW + ch * 16) = kr[j]; *(LAS u32x4*)(lds + WIN_V + row * VROW + ch * 16) = vr[j]; } }
}

__device__ __forceinline__ void attn_store(const bf16_t* __restrict__ Pz, int pitch, int tq, bf16_t* __restrict__ orow0  , int lane, float l, const f32x4 (&o)[4]) {
    const int g = lane >> 4;
    const float inv = 1.f / q4_sum(l);
#pragma unroll
    for (int n = 0; n < 4; ++n) {
        const u32x2 zw = *(const u32x2*)(Pz + (size_t)tq * pitch + 16 * n + 4 * g);
        const float a0 = o[n][0] * inv * silu_f(bf_lo(zw.x)), a1 = o[n][1] * inv * silu_f(bf_hi(zw.x));
        const float a2 = o[n][2] * inv * silu_f(bf_lo(zw.y)), a3 = o[n][3] * inv * silu_f(bf_hi(zw.y));
        u32x2 w; w.x = cvtpk(a0, a1); w.y = cvtpk(a2, a3);
        *(u32x2*)(orow0 + (size_t)tq * 1024 + 16 * n + 4 * g) = w;
    }
}

__device__ __forceinline__ void attn_a_phase(const bf16_t* P, bf16_t* A, int S, LAS unsigned char* lds, int wave, int lane_in, int tid_in) {
    int lane = lane_in, tid = tid_in; asm volatile("" : "+v"(lane), "+v"(tid));
    LAS unsigned char* vl = lds + wave * 10240;
    for (int bu = blockIdx.x; bu < 512; bu += gridDim.x) {
        const int tile = bu >> 4, h = bu & 15;
        const int tc0 = tile * 256, seq0 = (tc0 / S) * S, T = tc0 - seq0;
        const bf16_t* Ps = P + (size_t)seq0 * IN_A + h * 64;
        const float slope = __builtin_amdgcn_exp2f(-0.5f * (float)(h + 1)) * LOG2E;
        __syncthreads();
        stage_window(Ps + 1024, Ps + 2048, IN_A, S, T - 64, lds, tid);
        __syncthreads();
        float m[2], l[2]; f32x4 o[2][4]; int t0[2], tq[2];
        {
            int t0c[2], tqc[2], row0c[2];
#pragma unroll
            for (int it = 0; it < 2; ++it) {
                const int sub = wave + 8 * it; t0c[it] = T + 16 * sub; tqc[it] = t0c[it] + (lane & 15); row0c[it] = 16 * sub;
                m[it] = -1e30f; l[it] = 0.f;
#pragma unroll
                for (int n = 0; n < 4; ++n) o[it][n] = (f32x4){0.f, 0.f, 0.f, 0.f};
            }
            const bf16_t* const Pq[2] = {Ps, Ps}; const float sl[2] = {slope, slope};
            group_pass_lds<64, 1, 5, 2, false>(Pq, IN_A, S, tqc, sl, lds, row0c, t0c, lane, m, l, o);
        }
        __syncthreads();
#pragma unroll
        for (int it = 0; it < 2; ++it) {
            LAS float* row = (LAS float*)lds + (16 * (wave + 8 * it) + (lane & 15)) * 68;
#pragma unroll
            for (int n = 0; n < 4; ++n) *(LAS f32x4*)(row + 16 * n + 4 * (lane >> 4)) = o[it][n];
            const float lt = q4_sum(l[it]);
            if (lane < 16) { row[64] = m[it]; row[65] = lt; }
        }
        __syncthreads();
        asm volatile("" : "+v"(lane));
#pragma unroll
        for (int it = 0; it < 2; ++it) {
            const int res = wave + 8 * it; t0[it] = T + res; tq[it] = t0[it] + 16 * (lane & 15);
            const LAS float* row = (const LAS float*)lds + (res + 16 * (lane & 15)) * 68;
#pragma unroll
            for (int n = 0; n < 4; ++n) o[it][n] = *(const LAS f32x4*)(row + 16 * n + 4 * (lane >> 4));
            m[it] = row[64]; l[it] = (lane < 16) ? row[65] : 0.f;
        }
        __syncthreads();
#ifndef NO_A_GL
        group_pass<4, 64, 4, 6, 2>(Ps + 3072, Ps + 4096, Ps + 5120, IN_A, S, t0, tq, slope * 4.f, vl, lane, m, l, o);
        group_pass<16, 64, 1, 5, 2>(Ps + 6144, Ps + 7168, Ps + 8192, IN_A, S, t0, tq, slope * 16.f, vl, lane, m, l, o);
#endif
#pragma unroll
        for (int it = 0; it < 2; ++it) attn_store(Ps + 9216, IN_A, tq[it], A + (size_t)seq0 * 1024 + h * 64, lane, l[it], o[it]);
    }
}
__device__ __forceinline__ void attn_b_phase(const bf16_t* P, bf16_t* A, int S, const float* sink, LAS unsigned char* lds, int wave, int lane_in, int tid_in) {
    int lane = lane_in, tid = tid_in; asm volatile("" : "+v"(lane), "+v"(tid));
    for (int bu = blockIdx.x; bu < 1024; bu += gridDim.x) {
        const int tile = bu >> 2, kvh = bu & 3;
        const int tc0 = tile * 128, seq0 = (tc0 / S) * S, T = tc0 - seq0;
        const bf16_t* Ps = P + (size_t)seq0 * IN_B;
        __syncthreads();
        stage_window(Ps + 1024 + kvh * 64, Ps + 1280 + kvh * 64, IN_B, S, T - 128, lds, tid);
        __syncthreads();
#pragma unroll 1
        for (int it = 0; it < 2; ++it) {
            const int h0 = kvh * 4 + 2 * it, sub = wave, tqv = T + 16 * sub + (lane & 15);
            float m[2], l[2], sl[2]; f32x4 o[2][4]; const int tq[2] = {tqv, tqv}; const int row0[2] = {16 * sub, 16 * sub};
            const bf16_t* const Pq[2] = {Ps + h0 * 64, Ps + (h0 + 1) * 64};
#pragma unroll
            for (int x = 0; x < 2; ++x) { sl[x] = __builtin_amdgcn_exp2f(-0.5f * (float)(h0 + x + 1)) * LOG2E; m[x] = sink[h0 + x] * LOG2E; l[x] = (lane < 16) ? 1.f : 0.f;
#pragma unroll
                for (int n = 0; n < 4; ++n) o[x][n] = (f32x4){0.f, 0.f, 0.f, 0.f}; }
            { const int tb[2] = {T + 16 * sub, T + 16 * sub}; group_pass_lds<128, 1, 9, 2, true>(Pq, IN_B, S, tq, sl, lds, row0, tb, lane, m, l, o); }
#pragma unroll
            for (int x = 0; x < 2; ++x) attn_store(Ps + 1536 + (h0 + x) * 64, IN_B, tqv, A + (size_t)seq0 * 1024 + (h0 + x) * 64, lane, l[x], o[x]);
        }
    }
}

__device__ __forceinline__ unsigned f2bf(float f) { unsigned u = __builtin_bit_cast(unsigned, f); return (u + 0x7fffu + ((u >> 16) & 1u)) >> 16; }
__device__ __forceinline__ unsigned pk2(float lo, float hi) { return f2bf(lo) | (f2bf(hi) << 16); }
__device__ __forceinline__ void transpose_item(const float* __restrict__ W, int K, int N, bf16_t* __restrict__ WT, LAS float* scr, int item, int lane) {
    const int nblk = N / 32, kb = item / nblk, nb = item % nblk, k0 = 64 * kb, n0 = 32 * nb;
    float wv[32];
#pragma unroll
    for (int i = 0; i < 32; ++i) wv[i] = W[(size_t)(k0 + 2 * i + (lane >> 5)) * N + n0 + (lane & 31)];
#pragma unroll
    for (int i = 0; i < 32; ++i) scr[(2 * i + (lane >> 5)) * 33 + (lane & 31)] = wv[i];
    asm volatile("s_waitcnt lgkmcnt(0)" ::: "memory");
    const int c = lane & 7;
#pragma unroll
    for (int j = 0; j < 4; ++j) { const int n = (lane >> 3) + 8 * j; const LAS float* s = scr + (8 * c) * 33 + n;
        u32x4 o; o.x = pk2(s[0 * 33], s[1 * 33]); o.y = pk2(s[2 * 33], s[3 * 33]); o.z = pk2(s[4 * 33], s[5 * 33]); o.w = pk2(s[6 * 33], s[7 * 33]);
        *(u32x4*)(WT + (size_t)(n0 + n) * K + k0 + 8 * c) = o; }
    asm volatile("s_waitcnt lgkmcnt(0)" ::: "memory");
}

struct Args {
    const float *x_prompt, *x_sample, *c_prompt, *c_sample, *w_mod, *b_mod, *ln_g, *ln_b, *w_in_a, *w_out_a, *w_in_b, *w_out_b, *sink_b;
    float* out; unsigned char* ws; int ph_lo, ph_hi;
};

__global__ void __launch_bounds__(NWAVES * 64, 2) mk_fwd(Args a) {
    extern __shared__ __attribute__((aligned(16))) unsigned char lds_raw[];
    LAS unsigned char* lds = (LAS unsigned char*)lds_raw;
    cg::grid_group grid = cg::this_grid();
    const int wave = __builtin_amdgcn_readfirstlane((int)threadIdx.x >> 6);
#define lane0 hw_lane()
#define tid0 (wave * 64 + hw_lane())
    const int G = gridDim.x, gw = blockIdx.x * NWAVES + wave, NGW = G * NWAVES;
    unsigned char* ws = a.ws;
    float* mod = (float*)(ws + WS_MOD);
    bf16_t* WinA = (bf16_t*)(ws + WS_WINA); bf16_t* WoutA = (bf16_t*)(ws + WS_WOUTA); bf16_t* WinB = (bf16_t*)(ws + WS_WINB); bf16_t* WoutB = (bf16_t*)(ws + WS_WOUTB);
    bf16_t* U = (bf16_t*)(ws + WS_U); bf16_t* ATT = (bf16_t*)(ws + WS_ATT); bf16_t* PROJ = (bf16_t*)(ws + WS_PROJ);
    volatile LAS unsigned* bst = (volatile LAS unsigned*)(lds + 131072 + 64);
    if (threadIdx.x < 2) bst[threadIdx.x] = 0u;
    __syncthreads();
    XcdBarrier bar; bar.bar = (unsigned*)(ws + WS_BAR); bar.x = 0; bar.st = bst;
    if (a.ph_hi - a.ph_lo > 1) bar = xcd_barrier_post((unsigned*)(ws + WS_BAR), bst);
    int pc = 0;
#define RUN() (a.ph_lo <= pc && pc < a.ph_hi)
#define SEAM() do { if (a.ph_lo <= pc && pc + 1 < a.ph_hi) { if (pc == 0) grid.sync(); else xcd_barrier(bar); } ++pc; } while (0)

    if (RUN()) {
        int lane = lane0, tid = tid0; asm volatile("" : "+v"(lane), "+v"(tid));
        LAS float* scr = (LAS float*)(lds + wave * 16384);
        constexpr int I_INA = 16 * (IN_A / 32), I_OUT = 16 * 32, I_INB = 16 * (IN_B / 32);
        constexpr int NITEMS = 2 * I_INA + 2 * I_OUT + 2 * I_INB + 2 * I_OUT;
        for (int it = gw; it < NITEMS; it += NGW) {
            int r = it;
            if (r < 2 * I_INA) { const int li = r / I_INA; transpose_item(a.w_in_a + (size_t)li * DM * IN_A, DM, IN_A, WinA + (size_t)li * IN_A * DM, scr, r % I_INA, lane); continue; } r -= 2 * I_INA;
            if (r < 2 * I_OUT) { const int li = r / I_OUT; transpose_item(a.w_out_a + (size_t)li * DM * DM, DM, DM, WoutA + (size_t)li * DM * DM, scr, r % I_OUT, lane); continue; } r -= 2 * I_OUT;
            if (r < 2 * I_INB) { const int li = r / I_INB; transpose_item(a.w_in_b + (size_t)li * DM * IN_B, DM, IN_B, WinB + (size_t)li * IN_B * DM, scr, r % I_INB, lane); continue; } r -= 2 * I_INB;
            { const int li = r / I_OUT; transpose_item(a.w_out_b + (size_t)li * DM * DM, DM, DM, WoutB + (size_t)li * DM * DM, scr, r % I_OUT, lane); }
        }
        __syncthreads();
        LAS float* sc = (LAS float*)lds;
        for (int item = blockIdx.x; item < 192; item += G) {
            const int l = item / 48, r = item % 48, cgp = r >> 3, ks = r & 7;
            __syncthreads();
            for (int e = tid; e < NB * 128; e += NWAVES * 64) { const int b = e >> 7, k = ks * 128 + (e & 127);
                const float cv = b < 4 ? a.c_prompt[b * DM + k] : a.c_sample[(b - 4) * DM + k]; sc[e] = silu_f(cv); }
            __syncthreads();
            const int col = cgp * 512 + tid;
            float acc[NB];
#pragma unroll
            for (int b = 0; b < NB; ++b) acc[b] = 0.f;
            const float* wp = a.w_mod + ((size_t)l * DM + ks * 128) * 3072 + col;
#pragma unroll 1
            for (int k0 = 0; k0 < 128; k0 += 16) { float w[16];
#pragma unroll
                for (int kk = 0; kk < 16; ++kk) w[kk] = wp[(size_t)(k0 + kk) * 3072];
#pragma unroll
                for (int kk = 0; kk < 16; ++kk)
#pragma unroll
                    for (int b = 0; b < NB; ++b) acc[b] = fmaf(sc[b * 128 + k0 + kk], w[kk], acc[b]); }
            const float bias = (ks == 0) ? a.b_mod[l * 3072 + col] : 0.f;
#pragma unroll
            for (int b = 0; b < NB; ++b) atomicAdd(mod + ((size_t)l * NB + b) * 3072 + col, acc[b] + bias);
        }
    }
    SEAM();

    if (RUN()) {
        int lane = lane0; asm volatile("" : "+v"(lane));
        for (int row0 = 2 * gw; row0 < NTOK; row0 += 2 * NGW) {
            f32x4 xv[2][4];
#pragma unroll
            for (int rr = 0; rr < 2; ++rr) { const int row = row0 + rr;
                const float* xr = row < NPROMPT ? a.x_prompt + (size_t)row * DM : a.x_sample + (size_t)(row - NPROMPT) * DM;
#pragma unroll
                for (int j = 0; j < 4; ++j) xv[rr][j] = *(const f32x4*)(xr + 4 * lane + 256 * j); }
            const float* mp = mod + (size_t)batch_of_row(row0) * 3072;
#pragma unroll
            for (int j = 0; j < 4; ++j) { const int c = 4 * lane + 256 * j;
                const f32x4 sh = *(const f32x4*)(mp + c), scl = *(const f32x4*)(mp + 1024 + c) + 1.f;
#pragma unroll
                for (int rr = 0; rr < 2; ++rr) { const f32x4 uv = xv[rr][j] * scl + sh;
                    u32x2 w; w.x = cvtpk(uv[0], uv[1]); w.y = cvtpk(uv[2], uv[3]);
                    *(u32x2*)(U + (size_t)(row0 + rr) * DM + c) = w; } }
        }
    }
    SEAM();

#pragma unroll 1
    for (int l = 0; l < DEPTH; ++l) {
        const bool isA = (l & 1) == 0; const int li = l >> 1;
        const int nch = isA ? NCH_A : NCH_B, chrows = isA ? CH_A : CH_B, ncols = isA ? IN_A : IN_B;
        const bf16_t* Win = isA ? WinA + (size_t)li * IN_A * DM : WinB + (size_t)li * IN_B * DM;
        const bf16_t* Wout = isA ? WoutA + (size_t)li * DM * DM : WoutB + (size_t)li * DM * DM;
#pragma unroll 1
        for (int c = 0; c <= nch; ++c) {
            const bool isO = (c == nch);
            if (RUN()) {
                pg8::Gemm g{isO ? ATT : U + (size_t)c * chrows * DM, isO ? Wout : Win, isO ? NTOK : chrows, isO ? DM : ncols, DM}; pg8::StaticOrder S; S.init(g.M, g.N, G, (int)blockIdx.x);
                pg8::EpiBf16<0> E{PROJ, g.N, nullptr, 0, 0, CSCALE, isO ? 0 : (isA ? 1 : 2)};
                pg8::gemm_phase<pg8::EpiBf16<0>, pg8::StaticOrder, true, true>(lds, g, S, E, wave);
            }
            SEAM();
            if (isO) break;
            if (RUN()) {
                const int row0 = c * chrows; const int S_ = row0 < NPROMPT ? 8192 : 4096;
#ifndef NO_ATT
#ifndef NO_ATT_A
                if (isA) attn_a_phase(PROJ, ATT + (size_t)row0 * DM, S_, lds, wave, lane0, tid0);
#endif
#ifndef NO_ATT_B
                if (!isA) attn_b_phase(PROJ, ATT + (size_t)row0 * DM, S_, a.sink_b + li * 16, lds, wave, lane0, tid0);
#endif
#endif
            }
            SEAM();
        }
        if (RUN()) {
            int lane = lane0; asm volatile("" : "+v"(lane));
            const float* gam = a.ln_g + l * DM; const float* bet = a.ln_b + l * DM;
            const float* xa = l == 0 ? a.x_prompt : a.out; const float* xb = l == 0 ? a.x_sample : a.out + (size_t)NPROMPT * DM;
            for (int row0 = 2 * gw; row0 < NTOK; row0 += 2 * NGW) {
                f32x4 v[2][4]; u32x2 yw[2][4];
#pragma unroll
                for (int rr = 0; rr < 2; ++rr) { const int row = row0 + rr;
                    const float* xr = row < NPROMPT ? xa + (size_t)row * DM : xb + (size_t)(row - NPROMPT) * DM;
#pragma unroll
                    for (int j = 0; j < 4; ++j) { v[rr][j] = *(const f32x4*)(xr + 4 * lane + 256 * j); yw[rr][j] = *(const u32x2*)(PROJ + (size_t)row * DM + 4 * lane + 256 * j); } }
                const int b = batch_of_row(row0);
                const float* gp = mod + ((size_t)l * NB + b) * 3072 + 2048;
                const float* mp = mod + ((size_t)(l + 1) * NB + b) * 3072;
                float mean[2], rstd[2];
#pragma unroll
                for (int j = 0; j < 4; ++j) { const f32x4 gt = *(const f32x4*)(gp + 4 * lane + 256 * j);
#pragma unroll
                    for (int rr = 0; rr < 2; ++rr) { const f32x4 yv = (f32x4){bf_lo(yw[rr][j].x), bf_hi(yw[rr][j].x), bf_lo(yw[rr][j].y), bf_hi(yw[rr][j].y)};
                        v[rr][j] = v[rr][j] * 1.681792830507429f + gt * yv; } }
#pragma unroll
                for (int rr = 0; rr < 2; ++rr) { float s = 0.f;
#pragma unroll
                    for (int j = 0; j < 4; ++j) s += (v[rr][j][0] + v[rr][j][1]) + (v[rr][j][2] + v[rr][j][3]);
                    mean[rr] = wave_sum(s, lane) * (1.f / DM); float s2 = 0.f;
#pragma unroll
                    for (int j = 0; j < 4; ++j) { v[rr][j] = v[rr][j] - mean[rr]; s2 += (v[rr][j][0] * v[rr][j][0] + v[rr][j][1] * v[rr][j][1]) + (v[rr][j][2] * v[rr][j][2] + v[rr][j][3] * v[rr][j][3]); }
                    rstd[rr] = 1.f / sqrtf(wave_sum(s2, lane) * (1.f / DM) + LN_EPS); }
#pragma unroll
                for (int j = 0; j < 4; ++j) { const int cc = 4 * lane + 256 * j;
                    const f32x4 gm = *(const f32x4*)(gam + cc), bt = *(const f32x4*)(bet + cc);
                    f32x4 sh = (f32x4){0.f, 0.f, 0.f, 0.f}, scl = (f32x4){1.f, 1.f, 1.f, 1.f};
                    if (l + 1 < DEPTH) { sh = *(const f32x4*)(mp + cc); scl = *(const f32x4*)(mp + 1024 + cc) + 1.f; }
#pragma unroll
                    for (int rr = 0; rr < 2; ++rr) { const f32x4 xo = v[rr][j] * rstd[rr] * gm + bt;
                        *(f32x4*)(a.out + (size_t)(row0 + rr) * DM + cc) = xo;
                        if (l + 1 < DEPTH) { const f32x4 uv = xo * scl + sh; u32x2 w; w.x = cvtpk(uv[0], uv[1]); w.y = cvtpk(uv[2], uv[3]); *(u32x2*)(U + (size_t)(row0 + rr) * DM + cc) = w; } } }
            }
        }
        SEAM();
    }
#undef RUN
#undef SEAM
}

constexpr int N_PHASES = 2 + 2 * (2 * NCH_A + 2) + 2 * (2 * NCH_B + 2);
#ifndef ONE_LAUNCH
#define ONE_LAUNCH 1
#endif

extern "C" void kernel_launch(void* const* d_in, const int* in_sizes, int n_in, void* d_out, int out_size, void* d_ws, size_t ws_size, hipStream_t stream) {
    static int grid = 0;
    if (grid == 0) {
        if (n_in != 13 || out_size != NTOK * DM || ws_size < WS_END) { fprintf(stderr, "kernel_launch: unexpected shapes (n_in %d, out %d, ws %zu)\n", n_in, out_size, ws_size); grid = -1; return; }
        int dev = 0, cus = 0, per_cu = 0;
        (void)hipGetDevice(&dev); (void)hipDeviceGetAttribute(&cus, hipDeviceAttributeMultiprocessorCount, dev);
        if (hipFuncSetAttribute((const void*)mk_fwd, hipFuncAttributeMaxDynamicSharedMemorySize, LDS_BYTES) != hipSuccess) { fprintf(stderr, "kernel_launch: hipFuncSetAttribute failed\n"); grid = -1; return; }
        if (hipOccupancyMaxActiveBlocksPerMultiprocessor(&per_cu, (const void*)mk_fwd, NWAVES * 64, LDS_BYTES) != hipSuccess || per_cu < 1) per_cu = 1;
        (void)hipGetLastError();
        if (cus <= 0) cus = 256;
        grid = cus * per_cu;
    }
    if (grid < 0) return;
    (void)hipMemsetAsync((char*)d_ws + WS_MOD, 0, CTL_ZERO_BYTES, stream);
    Args a{};
    a.x_prompt = (const float*)d_in[0]; a.x_sample = (const float*)d_in[1]; a.c_prompt = (const float*)d_in[2]; a.c_sample = (const float*)d_in[3];
    a.w_mod = (const float*)d_in[4]; a.b_mod = (const float*)d_in[5]; a.ln_g = (const float*)d_in[6]; a.ln_b = (const float*)d_in[7];
    a.w_in_a = (const float*)d_in[8]; a.w_out_a = (const float*)d_in[9]; a.w_in_b = (const float*)d_in[10]; a.w_out_b = (const float*)d_in[11]; a.sink_b = (const float*)d_in[12];
    a.out = (float*)d_out; a.ws = (unsigned char*)d_ws;
#if ONE_LAUNCH
    a.ph_lo = 0; a.ph_hi = N_PHASES;
    void* params[] = {&a};
    hipError_t e = hipLaunchCooperativeKernel((const void*)mk_fwd, dim3(grid), dim3(NWAVES * 64), params, LDS_BYTES, stream);
    if (e != hipSuccess) fprintf(stderr, "kernel_launch: cooperative launch failed: %s (grid %d)\n", hipGetErrorString(e), grid);
#else
    for (int k = 0; k < N_PHASES; ++k) { a.ph_lo = k; a.ph_hi = k + 1; hipLaunchKernelGGL(mk_fwd, dim3(grid), dim3(NWAVES * 64), LDS_BYTES, stream, a); }
#endif
}
```
